# Optimizing an MI355X kernel written in HIP

```python
import math
import jax, jax.numpy as jnp
from jax import lax
import numpy as np

D_MODEL = 1024
BATCH = 4
SEQ = 8192
DEPTH = 2
DEC_BATCH = 2
DEC_SEQ = 16384
PAST_LEN = 128

HEAD_DIM = 64
MIX_W = D_MODEL
A_HEADS = 4
A_W = A_HEADS * HEAD_DIM
LORA = 64
B_HEADS = 4
B_W = B_HEADS * HEAD_DIM
DILATED_PAIRS = ((128, 1), (512, 4), (2048, 16))
C_HEADS = 8
C_KV_HEADS = 2
C_QW = C_HEADS * HEAD_DIM
C_KVW = C_KV_HEADS * HEAD_DIM
C_RADIUS = 128
ROPE_THETA = 10000.0
RMS_EPS = 1e-5
HEADNORM_EPS = 64e-5
NEG_INF = -1e30

SHIFT_SPLITS = (A_W, A_W, A_W, LORA, LORA, LORA, LORA)
TSHIFT_W = sum(SHIFT_SPLITS)
REST_SPLITS = (A_W, B_W, B_W, B_W, B_W, C_QW, C_KVW, C_KVW, C_QW)
IN_W = TSHIFT_W + sum(REST_SPLITS)

kernel_name = "hybrid_bidir_rwkv7_dilated_swa_encoder"


def _split(t, sizes):
    idx = [int(i) for i in np.cumsum(sizes)[:-1]]
    return jnp.split(t, idx, axis=-1)


def rms_norm(x, g):
    xf = x.astype(jnp.float32)
    y = xf * lax.rsqrt(jnp.mean(xf * xf, axis=-1, keepdims=True) + RMS_EPS)
    return (y * g.astype(jnp.float32)).astype(x.dtype)


def rope(t):
    T, hd = t.shape[1], t.shape[-1]
    inv = ROPE_THETA ** (-jnp.arange(0, hd, 2, dtype=jnp.float32) / hd)
    ang = jnp.arange(T, dtype=jnp.float32)[:, None] * inv[None, :]
    cos = jnp.cos(ang)[None, :, None, :]
    sin = jnp.sin(ang)[None, :, None, :]
    tf = t.astype(jnp.float32)
    t1, t2 = tf[..., : hd // 2], tf[..., hd // 2:]
    return jnp.concatenate([t1 * cos - t2 * sin, t2 * cos + t1 * sin], axis=-1).astype(t.dtype)


def centred_token_shift(f, mu):
    zero = jnp.zeros_like(f[:, :1])
    prev = jnp.concatenate([zero, f[:, :-1]], axis=1)
    nxt = jnp.concatenate([f[:, 1:], zero], axis=1)
    return f + mu * (0.5 * (prev + nxt) - f)


def banded_attention(q, k, v, radius, sink=None):
    b, L, hq, hd = q.shape
    hkv = k.shape[2]
    grp = hq // hkv
    blk = radius
    nb = -(-L // blk)
    lp = nb * blk
    q = jnp.pad(q, ((0, 0), (0, lp - L), (0, 0), (0, 0)))
    kv_pad = ((0, 0), (blk, lp - L + blk), (0, 0), (0, 0))
    k = jnp.pad(k, kv_pad).reshape(b, nb + 2, blk, hkv, hd)
    v = jnp.pad(v, kv_pad).reshape(b, nb + 2, blk, hkv, hd)
    kb = jnp.concatenate([k[:, :-2], k[:, 1:-1], k[:, 2:]], axis=2)
    vb = jnp.concatenate([v[:, :-2], v[:, 1:-1], v[:, 2:]], axis=2)
    qb = q.reshape(b, nb, blk, hkv, grp, hd)
    s = jnp.einsum('bnqhgd,bnkhd->bnhgqk', qb, kb,
                   preferred_element_type=jnp.float32) * (hd ** -0.5)
    qpos = jnp.arange(lp).reshape(nb, blk)
    kpos = (jnp.arange(nb)[:, None] - 1) * blk + jnp.arange(3 * blk)[None, :]
    kp = kpos[:, None, :]
    mask = (jnp.abs(kp - qpos[:, :, None]) <= radius) & (kp >= 0) & (kp < L)
    s = jnp.where(mask[None, :, None, None], s, NEG_INF)
    m = jnp.max(s, axis=-1, keepdims=True)
    if sink is not None:
        sk = sink.astype(jnp.float32).reshape(hkv, grp)[None, None, :, :, None, None]
        m = jnp.maximum(m, sk)
    p = jnp.exp(s - m)
    denom = jnp.sum(p, axis=-1, keepdims=True)
    if sink is not None:
        denom = denom + jnp.exp(sk - m)
    o = jnp.einsum('bnhgqk,bnkhd->bnhgqd', p, vb.astype(jnp.float32)) / denom
    o = o.transpose(0, 1, 4, 2, 3, 5).reshape(b, lp, hq, hd)[:, :L]
    lse = (m + jnp.log(denom))[..., 0].transpose(0, 1, 4, 2, 3).reshape(b, lp, hq)[:, :L]
    return o, lse


def dilated_mixture(q, k, v):
    b, T, h, hd = q.shape
    outs, lses = [], []
    for window, dil in DILATED_PAIRS:
        radius = window // (2 * dil)
        L = T // dil

        def to_strided(t):
            return t.reshape(b, L, dil, h, hd).transpose(0, 2, 1, 3, 4).reshape(b * dil, L, h, hd)

        o, lse = banded_attention(to_strided(q), to_strided(k), to_strided(v), radius)
        outs.append(o.reshape(b, dil, L, h, hd).transpose(0, 2, 1, 3, 4).reshape(b, T, h, hd))
        lses.append(lse.reshape(b, dil, L, h).transpose(0, 2, 1, 3).reshape(b, T, h))
    wts = jax.nn.softmax(jnp.stack(lses, axis=0), axis=0)
    return jnp.sum(wts[..., None] * jnp.stack(outs, axis=0), axis=0)


def wkv7_scan(r, w, k, v, kk, a, reverse):
    b, T, h, n = r.shape

    def step(S, inp):
        r_t, w_t, k_t, v_t, kk_t, a_t = inp
        sa = jnp.einsum('bhij,bhj->bhi', S, -kk_t)
        S = (S * w_t[:, :, None, :] + sa[..., :, None] * (kk_t * a_t)[..., None, :]
             + v_t[..., :, None] * k_t[..., None, :])
        return S, jnp.einsum('bhij,bhj->bhi', S, r_t)

    xs = tuple(jnp.moveaxis(z, 1, 0) for z in (r, w, k, v, kk, a))
    S0 = jnp.zeros((b, h, n, n), jnp.float32)
    _, y = lax.scan(step, S0, xs, reverse=reverse)
    return jnp.moveaxis(y, 0, 1)


def rwkv7_branch(r, k, v, wd, ad, w0, w2, a0, a2, k_k, k_a, r_k, ln_w, ln_b):
    f32 = jnp.float32
    b, t, _ = r.shape
    r, k, v = r.astype(f32), k.astype(f32), v.astype(f32)
    w = -jax.nn.softplus(-(w0 + jnp.einsum('btel,elc->btec', jnp.tanh(wd.astype(f32)), w2.astype(f32)))) - 0.5
    decay = jnp.exp(-jnp.exp(w))
    a = jax.nn.sigmoid(a0 + jnp.einsum('btel,elc->btec', ad.astype(f32), a2.astype(f32)))

    def heads(z):
        return z.reshape(b, t, A_HEADS, HEAD_DIM)

    kk = heads(k * k_k)
    kk = kk / jnp.maximum(jnp.sqrt(jnp.sum(kk * kk, axis=-1, keepdims=True)), 1e-12)
    k_eff = k[:, :, None, :] * (1.0 + (a - 1.0) * k_a)
    rh, vh = heads(r), heads(v)
    y_f = wkv7_scan(rh, heads(decay[:, :, 0]), heads(k_eff[:, :, 0]), vh, kk, heads(a[:, :, 0]), reverse=False)
    y_b = wkv7_scan(rh, heads(decay[:, :, 1]), heads(k_eff[:, :, 1]), vh, kk, heads(a[:, :, 1]), reverse=True)
    y = y_f + y_b
    mu = jnp.mean(y, axis=-1, keepdims=True)
    var = jnp.mean(jnp.square(y - mu), axis=-1, keepdims=True)
    yn = (y - mu) * lax.rsqrt(var + HEADNORM_EPS)
    yn = yn * ln_w.reshape(A_HEADS, HEAD_DIM) + ln_b.reshape(A_HEADS, HEAD_DIM)
    bonus = jnp.sum(rh * heads(k_eff[:, :, 0] + k_eff[:, :, 1]) * r_k, axis=-1, keepdims=True) * vh
    return (yn + bonus).reshape(b, t, A_W)


def hybrid_layer(x, norm_g, w_in, tshift_mu, rwkv_w0, rwkv_w2, rwkv_a0, rwkv_a2, rwkv_k_k, rwkv_k_a,
                 rwkv_r_k, ln_x_w, ln_x_b, attn_sink, w_out):
    b, t, _ = x.shape
    h = rms_norm(x, norm_g)
    proj = jnp.einsum('btd,de->bte', h, w_in)
    shifted = centred_token_shift(proj[..., :TSHIFT_W], tshift_mu)
    a_r, a_k, a_v, wd_f, wd_b, ad_f, ad_b = _split(shifted, SHIFT_SPLITS)
    a_g, b_q, b_k, b_v, b_g, c_q, c_k, c_v, c_g = _split(proj[..., TSHIFT_W:], REST_SPLITS)

    y_a = rwkv7_branch(a_r, a_k, a_v, jnp.stack([wd_f, wd_b], axis=2), jnp.stack([ad_f, ad_b], axis=2),
                       rwkv_w0, rwkv_w2, rwkv_a0, rwkv_a2, rwkv_k_k, rwkv_k_a, rwkv_r_k, ln_x_w, ln_x_b)
    bh = lambda z: z.reshape(b, t, B_HEADS, HEAD_DIM)
    y_b = dilated_mixture(rope(bh(b_q)), rope(bh(b_k)), bh(b_v)).reshape(b, t, B_W)
    y_c, _ = banded_attention(rope(c_q.reshape(b, t, C_HEADS, HEAD_DIM)),
                              rope(c_k.reshape(b, t, C_KV_HEADS, HEAD_DIM)),
                              c_v.reshape(b, t, C_KV_HEADS, HEAD_DIM), C_RADIUS, sink=attn_sink)
    y_c = y_c.reshape(b, t, C_QW)

    mix = jnp.concatenate([y_a.astype(x.dtype) * jax.nn.silu(a_g),
                           y_b.astype(x.dtype) * jax.nn.silu(b_g),
                           y_c.astype(x.dtype) * jax.nn.silu(c_g)], axis=-1)
    return x + jnp.einsum('btc,cd->btd', mix, w_out)


def trunk(x, norm_g, w_in, tshift_mu, rwkv_w0, rwkv_w2, rwkv_a0, rwkv_a2, rwkv_k_k, rwkv_k_a,
          rwkv_r_k, ln_x_w, ln_x_b, attn_sink, w_out, final_g):
    for l in range(DEPTH):
        x = hybrid_layer(x, norm_g[l], w_in[l], tshift_mu[l], rwkv_w0[l], rwkv_w2[l], rwkv_a0[l], rwkv_a2[l],
                         rwkv_k_k[l], rwkv_k_a[l], rwkv_r_k[l], ln_x_w[l], ln_x_b[l], attn_sink[l], w_out[l])
    return rms_norm(x, final_g)


def setup_inputs(seed: int = 0) -> dict:
    key = jax.random.key(seed)
    ks = jax.random.split(key, 20)
    nrm = jax.random.normal
    f32 = jnp.float32
    return {
        "x_prompt": nrm(ks[0], (BATCH, SEQ, D_MODEL), f32),
        "x_sample": nrm(ks[1], (DEC_BATCH, DEC_SEQ, D_MODEL), f32),
        "norm_g": 1.0 + 0.1 * nrm(ks[2], (DEPTH, D_MODEL), f32),
        "w_in": nrm(ks[3], (DEPTH, D_MODEL, IN_W), f32) * D_MODEL ** -0.5,
        "tshift_mu": jax.random.uniform(ks[4], (DEPTH, TSHIFT_W), f32),
        "rwkv_w0": -2.0 + nrm(ks[5], (DEPTH, 2, A_W), f32),
        "rwkv_w2": 0.1 * nrm(ks[6], (DEPTH, 2, LORA, A_W), f32),
        "rwkv_a0": 0.5 * nrm(ks[7], (DEPTH, 2, A_W), f32),
        "rwkv_a2": 0.1 * nrm(ks[8], (DEPTH, 2, LORA, A_W), f32),
        "rwkv_k_k": 0.85 + 0.05 * nrm(ks[9], (DEPTH, A_W), f32),
        "rwkv_k_a": 1.0 + 0.05 * nrm(ks[10], (DEPTH, A_W), f32),
        "rwkv_r_k": 0.1 * nrm(ks[11], (DEPTH, A_HEADS, HEAD_DIM), f32),
        "ln_x_w": 1.0 + 0.1 * nrm(ks[12], (DEPTH, A_W), f32),
        "ln_x_b": 0.01 * nrm(ks[13], (DEPTH, A_W), f32),
        "attn_sink": 0.5 * nrm(ks[14], (DEPTH, C_HEADS), f32),
        "w_out": nrm(ks[15], (DEPTH, MIX_W, D_MODEL), f32) * MIX_W ** -0.5,
        "final_g": 1.0 + 0.1 * nrm(ks[16], (D_MODEL,), f32),
    }


def reference(x_prompt, x_sample, norm_g, w_in, tshift_mu, rwkv_w0, rwkv_w2, rwkv_a0, rwkv_a2, rwkv_k_k,
              rwkv_k_a, rwkv_r_k, ln_x_w, ln_x_b, attn_sink, w_out, final_g):
    y_prompt = trunk(x_prompt, norm_g, w_in, tshift_mu, rwkv_w0, rwkv_w2, rwkv_a0, rwkv_a2, rwkv_k_k,
                     rwkv_k_a, rwkv_r_k, ln_x_w, ln_x_b, attn_sink, w_out, final_g)
    y_sample = trunk(x_sample, norm_g, w_in, tshift_mu, rwkv_w0, rwkv_w2, rwkv_a0, rwkv_a2, rwkv_k_k,
                     rwkv_k_a, rwkv_r_k, ln_x_w, ln_x_b, attn_sink, w_out, final_g)
    return (y_prompt, y_sample)
```

```cpp
#include <hip/hip_runtime.h>
#include <hip/hip_cooperative_groups.h>
#include <stdint.h>
#include <stdio.h>
#include <string.h>
namespace cg = cooperative_groups;

typedef unsigned short bf16_t;
using bf16x8 = __attribute__((ext_vector_type(8))) short;
using f32x4 = __attribute__((ext_vector_type(4))) float;
using u32x4 = __attribute__((ext_vector_type(4))) unsigned int;
using f32x2 = __attribute__((ext_vector_type(2))) float;

#define NTOK 65536
#ifndef DUP
#define DUP -1
#endif
#define DM 1024
#define SMEM_BYTES 75776

__device__ __forceinline__ float bf2f(bf16_t h) { return __uint_as_float(((unsigned)h) << 16); }
__device__ __forceinline__ unsigned cvt_pk_bf16(float lo, float hi) {
  unsigned r; asm("v_cvt_pk_bf16_f32 %0,%1,%2" : "=v"(r) : "v"(lo), "v"(hi)); return r;
}
__device__ __forceinline__ bf16_t f2bf(float f) { return (bf16_t)cvt_pk_bf16(f, f); }
__device__ __forceinline__ unsigned pack2(float a, float b) { return cvt_pk_bf16(a, b); }
__device__ __forceinline__ float wave_sum(float v) {
#pragma unroll
  for (int o = 32; o > 0; o >>= 1) v += __shfl_xor(v, o);
  return v;
}
__device__ __forceinline__ float wave_max(float v) {
#pragma unroll
  for (int o = 32; o > 0; o >>= 1) v = fmaxf(v, __shfl_xor(v, o));
  return v;
}
template <int CTRL>
__device__ __forceinline__ float dpp_add(float x) {
  int y = __builtin_amdgcn_update_dpp(0, __float_as_int(x), CTRL, 0xf, 0xf, true);
  return x + __int_as_float(y);
}
template <int CTRL>
__device__ __forceinline__ float dpp_get(float x) {
  return __int_as_float(__builtin_amdgcn_update_dpp(0, __float_as_int(x), CTRL, 0xf, 0xf, true));
}
__device__ __forceinline__ float red16(float x) {
  x = dpp_add<0xB1>(x);
  x = dpp_add<0x4E>(x);
  x = dpp_add<0x141>(x);
  x = dpp_add<0x140>(x);
  return x;
}
__device__ __forceinline__ float wave_sum_fast(float v) {
  v = red16(v);
  v += __shfl_xor(v, 16);
  v += __shfl_xor(v, 32);
  return v;
}
__device__ __forceinline__ int opaque_tid() { int t = threadIdx.x; asm volatile("" : "+v"(t)); return t; }
__device__ __forceinline__ float silu(float g) { return g / (1.f + __expf(-g)); }

#define XB_TMO      128
#define XB_XCNT(j)  (256  + 64 * (j))
#define XB_XSUB(j)  (1280 + 64 * (j))
#define XB_XGEN(j)  (2304 + 64 * (j))
#define XB_TOP      3328
#define XB_TOPGEN   3392
#define XCD_BAR_WORDS 3456
#define XB_SPIN_CAP (1u << 18)
#define LAS __attribute__((address_space(3)))

__device__ __forceinline__ unsigned xb_ld(unsigned* p)              { return __hip_atomic_load(p, __ATOMIC_RELAXED, __HIP_MEMORY_SCOPE_AGENT); }
__device__ __forceinline__ unsigned xb_add(unsigned* p, unsigned v) { return __hip_atomic_fetch_add(p, v, __ATOMIC_RELAXED, __HIP_MEMORY_SCOPE_AGENT); }
__device__ __forceinline__ unsigned xb_xcc_id() { return (unsigned)__builtin_amdgcn_s_getreg((3 << 11) | 20) & 0xFu; }
#define XB_SPIN(cond, bar) do { unsigned _sp = 0; while (cond) { __builtin_amdgcn_s_sleep(1); \
    if ((++_sp & 255u) == 0u) { if (xb_ld(&(bar)[XB_TMO])) break; if (_sp > XB_SPIN_CAP) { atomicAdd(&(bar)[XB_TMO], 1u); break; } } } } while (0)

struct XcdBarrier {
    unsigned total;
    unsigned* bar; unsigned x;
    volatile LAS unsigned* st;
};

__device__ __forceinline__ XcdBarrier xcd_barrier_post(unsigned* bar, volatile LAS unsigned* st, unsigned total, bool member) {
    XcdBarrier b; b.total = total; b.bar = bar; b.x = xb_xcc_id(); b.st = st;
    if (threadIdx.x == 0 && member) (void)xb_add(&bar[XB_XCNT(b.x)], 1u);
    return b;
}
__device__ __forceinline__ void xcd_barrier_complete(unsigned* bar, unsigned x, unsigned& nloc, unsigned& nx, unsigned G) {
    unsigned sum, cnt, mine, sp = 0u;
    for (;;) {
        sum = 0u; cnt = 0u; mine = 0u;
#pragma unroll
        for (unsigned j = 0; j < 16; ++j) { const unsigned c = xb_ld(&bar[XB_XCNT(j)]); sum += c; cnt += (c > 0u) ? 1u : 0u; mine = (j == x) ? c : mine; }
        if (sum == G) break;
        __builtin_amdgcn_s_sleep(1);
        if ((++sp & 255u) == 0u) { if (xb_ld(&bar[XB_TMO])) break; if (sp > XB_SPIN_CAP) { atomicAdd(&bar[XB_TMO], 1u); break; } }
    }
    nloc = mine > 0u ? mine : 1u; nx = cnt > 0u ? cnt : 1u;
}

__device__ __forceinline__ void xcd_barrier(const XcdBarrier& b) {
    asm volatile("s_waitcnt vmcnt(0)" ::: "memory");
    __syncthreads();
    if (threadIdx.x == 0) {
        unsigned* bar = b.bar;
        __builtin_amdgcn_s_waitcnt(0);
        unsigned nloc = b.st[0], nx = b.st[1];
        if (nloc == 0u) { xcd_barrier_complete(bar, b.x, nloc, nx, b.total); b.st[0] = nloc; b.st[1] = nx; }
        const unsigned old = xb_add(&bar[XB_XSUB(b.x)], 1u);
        const unsigned gen = old / nloc;
        if (old + 1u == (gen + 1u) * nloc) {
            __builtin_amdgcn_fence(__ATOMIC_RELEASE, "agent");
            asm volatile("s_waitcnt vmcnt(0)" ::: "memory");
            const unsigned og = xb_add(&bar[XB_TOP], 1u);
            const unsigned tg = og / nx;
            if (og + 1u == (tg + 1u) * nx) xb_add(&bar[XB_TOPGEN], 1u);
            else XB_SPIN(xb_ld(&bar[XB_TOPGEN]) == tg, bar);
            __builtin_amdgcn_fence(__ATOMIC_ACQUIRE, "agent");
            xb_add(&bar[XB_XGEN(b.x)], 1u);
            asm volatile("s_waitcnt vmcnt(0)" ::: "memory");
        } else {
            XB_SPIN(xb_ld(&bar[XB_XGEN(b.x)]) == gen, bar);
            __builtin_amdgcn_fence(__ATOMIC_ACQUIRE, "agent");
            asm volatile("s_waitcnt vmcnt(0)" ::: "memory");
        }
    }
    __syncthreads();
}


struct Params {
  const float* xin0; const float* xin1;
  const float* norm_g; const float* w_in; const float* mu; const float* w0; const float* w2; const float* a0;
  const float* a2; const float* k_k; const float* k_a; const float* r_k; const float* ln_w; const float* ln_b;
  const float* sink; const float* w_out; const float* final_g;
  float* out;
  bf16_t* WinT; bf16_t* WoutT;
  bf16_t* Tb; bf16_t* proj2; bf16_t* PX;
  bf16_t* yf; bf16_t* yb; float* bonus; bf16_t* xb2;
  bf16_t* obuf; float* lse; float2* ropetab; float* g16; uint2* lw; bf16_t* lwT;
  unsigned* bar;
  int npass; int ntok_pass;
};

struct Rg { int lo, hi, br, nb; bf16_t* xb; int xbase; int xr, xn; };
__device__ __forceinline__ void seqinfo(int g, int& s0, int& T) {
  if (g < 32768) { T = 8192; s0 = g & ~8191; } else { T = 16384; s0 = g & ~16383; }
}
__device__ __forceinline__ const float* xrow(const Params& p, int g) {
  return g < 32768 ? p.xin0 + (size_t)g * DM : p.xin1 + (size_t)(g - 32768) * DM;
}

__device__ __forceinline__ void phase_wconv(const Params& p, char* smem) {
  const int TIDX = opaque_tid();
  for (int idx = blockIdx.x * 256 + TIDX; idx < 2 * 64 * 256; idx += gridDim.x * 256) {
    int layer = idx >> 14, l = (idx >> 8) & 63, cc = idx & 255;
    size_t of = (size_t)((layer * 2 + 0) * 64 + l) * 256 + cc, ob = (size_t)((layer * 2 + 1) * 64 + l) * 256 + cc;
    uint2 o; o.x = pack2(p.w2[of], p.w2[ob]); o.y = pack2(p.a2[of], p.a2[ob]);
    p.lw[idx] = o;
  }
  for (int idx = blockIdx.x * 256 + TIDX; idx < 2 * 4 * 256 * 64; idx += gridDim.x * 256) {
    int l = idx & 63, cc = (idx >> 6) & 255, g = (idx >> 14) & 3, layer = idx >> 16;
    const float* srcw = (g < 2) ? p.w2 : p.a2;
    p.lwT[idx] = f2bf(srcw[(size_t)((layer * 2 + (g & 1)) * 64 + l) * 256 + cc]);
  }
  for (int idx = blockIdx.x * 256 + TIDX; idx < 16384 * 32; idx += gridDim.x * 256) {
    int t = idx >> 5, fi = idx & 31;
    double inv = exp2(-(double)fi * (13.287712379549449 / 32.0));
    double ang = (double)t * inv;
    double sn, cs; sincos(ang, &sn, &cs);
    p.ropetab[idx] = make_float2((float)cs, (float)sn);
  }
  float (*tile)[65] = (float (*)[65])smem;
  const int per_layer = 16 * 56 + 16 * 16;
  for (int it = blockIdx.x; it < 2 * per_layer; it += gridDim.x) {
    int l = it / per_layer, r = it % per_layer;
    const float* src; bf16_t* dst; int N, kt, nt;
    if (r < 896) { kt = r / 56; nt = r % 56; src = p.w_in + (size_t)l * 1024 * 3584; dst = p.WinT + (size_t)l * 3584 * 1024; N = 3584; }
    else { r -= 896; kt = r / 16; nt = r % 16; src = p.w_out + (size_t)l * 1024 * 1024; dst = p.WoutT + (size_t)l * 1024 * 1024; N = 1024; }
    for (int e = TIDX; e < 4096; e += 256) { int i = e >> 6, j = e & 63; tile[i][j] = src[(size_t)(kt * 64 + i) * N + nt * 64 + j]; }
    __syncthreads();
    for (int e = TIDX; e < 4096; e += 256) { int j = e >> 6, i = e & 63; dst[(size_t)(nt * 64 + j) * 1024 + kt * 64 + i] = f2bf(tile[i][j]); }
    __syncthreads();
  }
}

__device__ __forceinline__ void phase_xnorm(const Params& p, int layer, int g0, const Rg& rg) {
  const int TIDX = opaque_tid();
  int wave = TIDX >> 6, lane = TIDX & 63;
  const float4* gam = (const float4*)(p.norm_g + layer * 1024);
  const int stride = rg.nb * 4;
  for (int ia = rg.lo + rg.br * 4 + wave; ia < rg.hi; ia += 2 * stride) {
    const int ib = ia + stride; const bool hb = ib < rg.hi;
    const float4* xa = (const float4*)((layer == 0) ? xrow(p, g0 + ia) : (p.out + (size_t)(g0 + ia) * DM));
    const float4* xb = (const float4*)((layer == 0) ? xrow(p, g0 + (hb ? ib : ia)) : (p.out + (size_t)(g0 + (hb ? ib : ia)) * DM));
    float4 va[4], vb[4]; float sa = 0.f, sb = 0.f;
#pragma unroll
    for (int q = 0; q < 4; q++) { va[q] = xa[q * 64 + lane]; vb[q] = xb[q * 64 + lane]; }
#pragma unroll
    for (int q = 0; q < 4; q++) {
      sa += va[q].x * va[q].x + va[q].y * va[q].y + va[q].z * va[q].z + va[q].w * va[q].w;
      sb += vb[q].x * vb[q].x + vb[q].y * vb[q].y + vb[q].z * vb[q].z + vb[q].w * vb[q].w;
    }
    sa = wave_sum_fast(sa); sb = wave_sum_fast(sb);
    float ra = rsqrtf(sa * (1.f / 1024.f) + 1e-5f), rb = rsqrtf(sb * (1.f / 1024.f) + 1e-5f);
    uint2* da = (uint2*)(rg.xb + (size_t)(ia - rg.xbase) * 1024);
    uint2* db = (uint2*)(rg.xb + (size_t)(ib - rg.xbase) * 1024);
#pragma unroll
    for (int q = 0; q < 4; q++) {
      float4 gg = gam[q * 64 + lane];
      uint2 o; o.x = pack2(va[q].x * ra * gg.x, va[q].y * ra * gg.y); o.y = pack2(va[q].z * ra * gg.z, va[q].w * ra * gg.w);
      da[q * 64 + lane] = o;
      if (hb) { uint2 o2; o2.x = pack2(vb[q].x * rb * gg.x, vb[q].y * rb * gg.y); o2.y = pack2(vb[q].z * rb * gg.z, vb[q].w * rb * gg.w); db[q * 64 + lane] = o2; }
    }
  }
}

template <int MODE>
__device__ __forceinline__ void phase_gemm(const Params& p, int layer, int g0, const Rg& rg, char* smem, int colset) {
  const int TIDX = opaque_tid();
  const int tid = TIDX, wave = tid >> 6, lane = tid & 63, wm = wave >> 1, wn = wave & 1, fr = lane & 15, fq = lane >> 4;
  const int NT = (MODE == 0) ? 28 : 8;
  const bf16_t* A = (MODE == 0) ? rg.xb : p.Tb;
  const int abase = (MODE == 0) ? rg.xbase : 0;
  const bf16_t* Bt = (MODE == 0) ? (p.WinT + (size_t)layer * 3584 * 1024) : (p.WoutT + (size_t)layer * 1024 * 1024);
  const int xcd = blockIdx.x & 7, rgp = xcd >> 2, cgp = xcd & 3;
  const int tm0 = rg.lo >> 8, ntmh = (rg.hi - rg.lo) >> 9;
  const int cpg = (MODE == 0) ? (colset == 0 ? 7 : (colset == 1 ? 6 : 1)) : 2;
  const int nloc = ntmh * cpg;
  for (int q = rg.xr; q < nloc; q += rg.xn) {
    const int tm = tm0 + rgp * ntmh + q / cpg;
    const int tni = cgp * cpg + q % cpg;
    int tn = tni;
    if (MODE == 0 && colset == 1) tn = (tni < 8) ? tni : ((tni < 14) ? tni + 2 : tni + 4);
    if (MODE == 0 && colset == 2) tn = (tni < 2) ? 8 + tni : 14 + tni;
    const bf16_t* Ag = A + (size_t)(tm * 256 - abase) * 1024;
    const bf16_t* Bg = Bt + (size_t)(tn * 128) * 1024;
    f32x4 acc[8][4];
#pragma unroll
    for (int a = 0; a < 8; a++)
#pragma unroll
      for (int b = 0; b < 4; b++) acc[a][b] = (f32x4){0.f, 0.f, 0.f, 0.f};
    const int g_r = lane >> 2, g_c = (lane & 3) * 8;
#define G_GLDS(BUF, K0) { char* As_ = smem + (BUF) * 24576; char* Bs_ = As_ + 16384; \
      _Pragma("unroll") for (int i = 0; i < 4; i++) { const int rr = (wave + i * 4) * 16 + g_r; \
      __builtin_amdgcn_global_load_lds((const unsigned*)(Ag + (size_t)rr * 1024 + (K0) + g_c), (LAS unsigned*)(As_ + (wave + i * 4) * 1024), 16, 0, 0); } \
      _Pragma("unroll") for (int i = 0; i < 2; i++) { const int rr = (wave + i * 4) * 16 + g_r; \
      __builtin_amdgcn_global_load_lds((const unsigned*)(Bg + (size_t)rr * 1024 + (K0) + g_c), (LAS unsigned*)(Bs_ + (wave + i * 4) * 1024), 16, 0, 0); } }
    asm volatile("s_waitcnt vmcnt(0)" ::: "memory");
    G_GLDS(0, 0);
    G_GLDS(1, 32);
    int cur = 0;
    for (int kt = 0; kt < 32; kt++) {
      if (kt < 31) asm volatile("s_waitcnt vmcnt(6)\n\ts_waitcnt lgkmcnt(0)\n\ts_barrier" ::: "memory");
      else asm volatile("s_waitcnt vmcnt(0)\n\ts_waitcnt lgkmcnt(0)\n\ts_barrier" ::: "memory");
      const int nxt2 = (cur == 0) ? 2 : cur - 1;
      const bf16_t* Ac = (const bf16_t*)(smem + cur * 24576);
      const bf16_t* Bc = Ac + 8192;
      bf16x8 af[8], bfr[4];
#pragma unroll
      for (int nt = 0; nt < 4; nt++) bfr[nt] = *(const bf16x8*)(Bc + (wn * 64 + nt * 16 + fr) * 32 + fq * 8);
#pragma unroll
      for (int mt = 7; mt >= 0; mt--) af[mt] = *(const bf16x8*)(Ac + (wm * 128 + mt * 16 + fr) * 32 + fq * 8);
      __builtin_amdgcn_sched_barrier(0);
#pragma unroll
      for (int mt = 0; mt < 8; mt++)
#pragma unroll
        for (int nt = 0; nt < 4; nt++)
          acc[mt][nt] = __builtin_amdgcn_mfma_f32_16x16x32_bf16(bfr[nt], af[mt], acc[mt][nt], 0, 0, 0);
      __builtin_amdgcn_sched_barrier(0);
      if (kt + 2 < 32) G_GLDS(nxt2, (kt + 2) * 32);
      cur = (cur == 2) ? 0 : cur + 1;
    }
    asm volatile("s_waitcnt lgkmcnt(0)\n\ts_barrier" ::: "memory");
#undef G_GLDS
    if (MODE == 0) {
      const int hc = tn * 128 + wn * 64;
      const bool rope = (hc >= 1280 && hc < 1792) || (hc >= 2304 && hc < 2944);
      const float sc = ((hc >= 1280 && hc < 1536) || (hc >= 2304 && hc < 2816)) ? (0.125f * 1.4426950408889634f) : 1.f;
#pragma unroll
      for (int mt = 0; mt < 8; mt++) {
        const int i = tm * 256 + wm * 128 + mt * 16 + fr;
        if (rope) {
          int g = g0 + i, s0, T; seqinfo(g, s0, T); const int t = g - s0;
          const float2* tab = p.ropetab + (size_t)t * 32;
#pragma unroll
          for (int nt = 0; nt < 2; nt++) {
            const float4 cs01 = *(const float4*)(tab + nt * 16 + fq * 4);
            const float4 cs23 = *(const float4*)(tab + nt * 16 + fq * 4 + 2);
            const float cc[4] = {cs01.x, cs01.z, cs23.x, cs23.z};
            const float ss[4] = {cs01.y, cs01.w, cs23.y, cs23.w};
#pragma unroll
            for (int j = 0; j < 4; j++) {
              float x1 = acc[mt][nt][j], x2 = acc[mt][nt + 2][j];
              acc[mt][nt][j] = (x1 * cc[j] - x2 * ss[j]) * sc;
              acc[mt][nt + 2][j] = (x2 * cc[j] + x1 * ss[j]) * sc;
            }
          }
        }
        char* strow = smem + (wm * 128 + mt * 16 + fr) * 272 + (wn * 64 + fq * 4) * 2;
#pragma unroll
        for (int nt = 0; nt < 4; nt++) {
          uint2 o; o.x = cvt_pk_bf16(acc[mt][nt][0], acc[mt][nt][1]); o.y = cvt_pk_bf16(acc[mt][nt][2], acc[mt][nt][3]);
          *(uint2*)(strow + nt * 32) = o;
        }
      }
      __syncthreads();
      {
        const int col0 = tn * 128;
        bf16_t* base; size_t stride;
        if (col0 < 1024) { base = p.Tb + col0; stride = 1024; } else { base = p.proj2 + (col0 - 1024); stride = 2560; }
        const int c16 = tid & 15, r0 = tid >> 4;
#pragma unroll
        for (int i = 0; i < 16; i++) {
          const int row = r0 + i * 16;
          u32x4 v = *(const u32x4*)(smem + row * 272 + c16 * 16);
          *(u32x4*)(base + (size_t)(tm * 256 + row) * stride + c16 * 8) = v;
        }
      }
      __syncthreads();
    } else {
#pragma unroll
      for (int mt = 0; mt < 8; mt++) {
        const int i = tm * 256 + wm * 128 + mt * 16 + fr, g = g0 + i;
        const int col0 = tn * 128 + wn * 64;
        const float* xr = (layer == 0) ? (xrow(p, g) + col0) : (p.out + (size_t)g * DM + col0);
        float* orow = p.out + (size_t)g * DM + col0;
#pragma unroll
        for (int nt = 0; nt < 4; nt++) {
          float4 xv = *(const float4*)(xr + nt * 16 + fq * 4);
          float4 o; o.x = xv.x + acc[mt][nt][0]; o.y = xv.y + acc[mt][nt][1]; o.z = xv.z + acc[mt][nt][2]; o.w = xv.w + acc[mt][nt][3];
          *(float4*)(orow + nt * 16 + fq * 4) = o;
        }
      }
    }
  }
}

__device__ __forceinline__ float shiftv(const bf16_t* tb, int r, int col, float mu) {
  float f = bf2f(tb[(r + 1) * 1024 + col]);
  float pv = bf2f(tb[r * 1024 + col]);
  float nx = bf2f(tb[(r + 2) * 1024 + col]);
  return f + mu * (0.5f * (pv + nx) - f);
}

__device__ __forceinline__ void phase_prep(const Params& p, int layer, int g0, int n, const Rg& rg, char* smem) {
  const int TIDX = opaque_tid();
  bf16_t* linb = (bf16_t*)smem;
  float* zbuf = (float*)(smem + 8704);
  bf16_t* tb = (bf16_t*)(smem + 8704 + 16640);
  const int TT = 16;
  const int c = TIDX, wave = c >> 6;
  const float* mu = p.mu + layer * 1024;
  const float mu_r = mu[c], mu_k = mu[256 + c], mu_v = mu[512 + c], mu_l = mu[768 + c];
  const float kkc = p.k_k[layer * 256 + c], kac = p.k_a[layer * 256 + c], rkc = p.r_k[layer * 256 + c];
  const float w0f = p.w0[(layer * 2 + 0) * 256 + c], w0b = p.w0[(layer * 2 + 1) * 256 + c];
  const float a0f = p.a0[(layer * 2 + 0) * 256 + c], a0b = p.a0[(layer * 2 + 1) * 256 + c];
  const uint2* lwp = p.lw + (size_t)layer * 64 * 256 + c;
  const float* w2f = p.w2 + (size_t)((layer * 2 + 0) * 64) * 256 + c;
  const float* w2b = p.w2 + (size_t)((layer * 2 + 1) * 64) * 256 + c;
  const float* a2f = p.a2 + (size_t)((layer * 2 + 0) * 64) * 256 + c;
  const float* a2b = p.a2 + (size_t)((layer * 2 + 1) * 64) * 256 + c;
  const size_t PS = (size_t)n * 256;
  bf16_t* Pv = p.PX;
  for (int tile = (rg.lo >> 4) + rg.br; tile < (rg.hi >> 4); tile += rg.nb) {
    const int i0 = tile * TT;
    {
      int g = g0 + i0, s0, T; seqinfo(g, s0, T); int t0 = g - s0;
#pragma unroll
      for (int q = 0; q < 9; q++) {
        int ch = c + q * 256;
        int r = ch >> 7, cc = ch & 127;
        int t = t0 - 1 + r;
        u32x4 v = (u32x4){0u, 0u, 0u, 0u};
        if (t >= 0 && t < T) v = *(const u32x4*)(p.Tb + (size_t)(i0 - 1 + r) * 1024 + cc * 8);
        *(u32x4*)(tb + r * 1024 + cc * 8) = v;
      }
    }
    __syncthreads();
#pragma unroll 4
    for (int tk = 0; tk < TT; tk++) {
      float sh = shiftv(tb, tk, 768 + c, mu_l);
      if (c < 128) { float e2 = __expf(2.f * sh); sh = 1.f - 2.f / (e2 + 1.f); }
      linb[tk * 272 + c] = f2bf(sh);
    }
    __syncthreads();
    float zwf[TT], zwb[TT], zaf[TT], zab[TT];
#pragma unroll
    for (int tk = 0; tk < TT; tk++) { zwf[tk] = w0f; zwb[tk] = w0b; zaf[tk] = a0f; zab[tk] = a0b; }
    {
      const int lane = c & 63, fr = lane & 15, fq = lane >> 4;
#pragma unroll
      for (int gq = 0; gq < 4; gq++) {
        f32x4 acc[4];
#pragma unroll
        for (int nt = 0; nt < 4; nt++) acc[nt] = (f32x4){0.f, 0.f, 0.f, 0.f};
#pragma unroll
        for (int ks = 0; ks < 2; ks++) {
          bf16x8 av = *(const bf16x8*)(linb + fr * 272 + gq * 64 + ks * 32 + fq * 8);
#pragma unroll
          for (int nt = 0; nt < 4; nt++) {
            bf16x8 bv = *(const bf16x8*)(p.lwT + ((size_t)((layer * 4 + gq) * 256 + wave * 64 + nt * 16 + fr)) * 64 + ks * 32 + fq * 8);
            acc[nt] = __builtin_amdgcn_mfma_f32_16x16x32_bf16(av, bv, acc[nt], 0, 0, 0);
          }
        }
#pragma unroll
        for (int nt = 0; nt < 4; nt++)
#pragma unroll
          for (int jx = 0; jx < 4; jx++) zbuf[(fq * 4 + jx) * 260 + wave * 64 + nt * 16 + fr] = acc[nt][jx];
        __syncthreads();
#pragma unroll
        for (int tk = 0; tk < TT; tk++) {
          float zv = zbuf[tk * 260 + c];
          if (gq == 0) zwf[tk] += zv; else if (gq == 1) zwb[tk] += zv; else if (gq == 2) zaf[tk] += zv; else zab[tk] += zv;
        }
        __syncthreads();
      }
    }
    float gf[TT], gb[TT];
#pragma unroll
    for (int tk = 0; tk < TT; tk++) {
#pragma unroll
      for (int e = 0; e < 2; e++) {
        float nz = -(e ? zwb[tk] : zwf[tk]);
        float sp = fmaxf(nz, 0.f) + __logf(1.f + __expf(-fabsf(nz)));
        float dec = __expf(-__expf(-sp - 0.5f));
        if (e) gb[tk] = dec; else gf[tk] = dec;
      }
    }
#pragma unroll
    for (int tk = 1; tk < TT; tk++) gf[tk] *= gf[tk - 1];
#pragma unroll
    for (int tk = TT - 2; tk >= 0; tk--) gb[tk] *= gb[tk + 1];
    p.g16[(size_t)tile * 512 + c] = gf[TT - 1];
    p.g16[(size_t)tile * 512 + 256 + c] = gb[0];
#pragma unroll
    for (int tk = 0; tk < TT; tk++) {
      int i = i0 + tk;
      float r = shiftv(tb, tk, c, mu_r);
      float k = shiftv(tb, tk, 256 + c, mu_k);
      float v = shiftv(tb, tk, 512 + c, mu_v);
      float kk = k * kkc;
      float ss = wave_sum_fast(kk * kk);
      kk = kk / fmaxf(sqrtf(ss), 1e-12f);
      float keffsum = 0.f;
#pragma unroll
      for (int e = 0; e < 2; e++) {
        float za = e ? zab[tk] : zaf[tk];
        float a = 1.f / (1.f + __expf(-za));
        float keff = k * (1.f + (a - 1.f) * kac);
        float b = kk * a;
        keffsum += keff;
        float gcur = e ? gb[tk] : gf[tk];
        float gprev = e ? (tk < TT - 1 ? gb[tk + 1] : 1.f) : (tk > 0 ? gf[tk - 1] : 1.f);
        float ginv = 1.f / gcur;
        unsigned* b32 = (unsigned*)(p.PX + (size_t)(1 + 4 * e) * PS);
        b32[(size_t)i * 256 + c] = cvt_pk_bf16(kk * gprev, r * gcur);
        b32[PS + (size_t)i * 256 + c] = cvt_pk_bf16(keff * ginv, b * ginv);
      }
      float bon = wave_sum_fast(r * keffsum * rkc);
      if ((c & 63) == 0) p.bonus[i * 4 + wave] = bon;
      Pv[(size_t)i * 256 + c] = f2bf(v);
    }
    __syncthreads();
  }
}

__device__ __forceinline__ void scan_item(const Params& p, int n, int iS, int T, int h, int e, int rg, char* smem) {
  const int TIDX = opaque_tid();
  const int TC = 16, RS = 256, BUFS = TC * 256 + 256;
  float* buf = (float*)smem;
  float* yS = buf + 2 * BUFS;
  const int tid = TIDX, wave = tid >> 6, lane = tid & 63, rl = wave * 4 + (lane >> 4), cs = lane & 15;
  const size_t PS = (size_t)n * 256;
  const bf16_t* Pv = p.PX;
  const unsigned* PAR = (const unsigned*)(p.PX + (size_t)(1 + 4 * e) * PS); const unsigned* PKB = PAR + PS;
  bf16_t* ydst = e ? p.yb : p.yf;
  const int nch = T / TC;
  const int ss = tid >> 4, jj = tid & 15;
  u32x4 rAR, rKB; bf16_t rv; f32x4 g16n;
#define SCAN_PREFETCH(CK) { int step = (CK) * TC + ss; int i = iS + (e ? (T - 1 - step) : step); \
    size_t o = (size_t)i * 256 + h * 64 + jj * 4; \
    rAR = *(const u32x4*)(PAR + o); rKB = *(const u32x4*)(PKB + o); \
    rv = Pv[(size_t)i * 256 + h * 64 + rg * 16 + jj]; \
    int tl = (iS + (e ? (T - TC * ((CK) + 1)) : (CK) * TC)) >> 4; \
    g16n = *(const f32x4*)(p.g16 + (size_t)tl * 512 + e * 256 + h * 64 + cs * 4); }
#define UNPK2(dst, src, OLO, OHI) { float4 f, g_; f.x = __uint_as_float(src.x << 16); f.y = __uint_as_float(src.y << 16); \
    f.z = __uint_as_float(src.z << 16); f.w = __uint_as_float(src.w << 16); \
    g_.x = __uint_as_float(src.x & 0xffff0000u); g_.y = __uint_as_float(src.y & 0xffff0000u); \
    g_.z = __uint_as_float(src.z & 0xffff0000u); g_.w = __uint_as_float(src.w & 0xffff0000u); \
    *(float4*)(dst + OLO + jj * 4) = f; *(float4*)(dst + OHI + jj * 4) = g_; }
#define UNPK(dst, src, OFS) { float4 f; f.x = __uint_as_float(src.x << 16); f.y = __uint_as_float(src.x & 0xffff0000u); \
    f.z = __uint_as_float(src.y << 16); f.w = __uint_as_float(src.y & 0xffff0000u); *(float4*)(dst + OFS + jj * 4) = f; }
  SCAN_PREFETCH(0);
  if (T > 8192) __builtin_amdgcn_s_setprio(3); else __builtin_amdgcn_s_setprio(2);
  f32x2 Xa = (f32x2){0.f, 0.f}, Xb = (f32x2){0.f, 0.f};
  for (int ck = 0; ck < nch; ck++) {
    float* B = buf + (ck & 1) * BUFS;
    {
      float* q = B + ss * RS;
      UNPK2(q, rAR, 0, 64);
      UNPK2(q, rKB, 128, 192);
      B[TC * 256 + jj * 16 + ss] = bf2f(rv);
    }
    const f32x4 g16 = g16n;
    __syncthreads();
    if (ck + 1 < nch) SCAN_PREFETCH(ck + 1);
    float yp[TC];
    f32x4 Aq[3], Rq[3], Kq[3], Bq[3];
    f32x4 v4[4];
#pragma unroll
    for (int q4 = 0; q4 < 4; q4++) v4[q4] = *(const f32x4*)(B + TC * 256 + rl * 16 + q4 * 4);
#define SCAN_LD(S) { const float* q_ = B + (S) * 256; Aq[(S) % 3] = *(const f32x4*)(q_ + cs * 4); Rq[(S) % 3] = *(const f32x4*)(q_ + 64 + cs * 4); \
      Kq[(S) % 3] = *(const f32x4*)(q_ + 128 + cs * 4); Bq[(S) % 3] = *(const f32x4*)(q_ + 192 + cs * 4); }
    SCAN_LD(0); SCAN_LD(1);
#pragma unroll
    for (int s = 0; s < TC; s++) {
      if (s + 2 < TC) SCAN_LD(s + 2);
      f32x4 A = Aq[s % 3], Rr = Rq[s % 3], K = Kq[s % 3], Bv = Bq[s % 3];
      float v = v4[s >> 2][s & 3];
      f32x2 vv = (f32x2){v, v};
      f32x2 pp2 = __builtin_elementwise_fma(Xb, A.zw, Xa * A.xy);
      f32x2 Ua = __builtin_elementwise_fma(vv, K.xy, Xa);
      f32x2 Ub = __builtin_elementwise_fma(vv, K.zw, Xb);
      float pp = red16(pp2.x + pp2.y);
      f32x2 nu = (f32x2){-pp, -pp};
      Xa = __builtin_elementwise_fma(nu, Bv.xy, Ua);
      Xb = __builtin_elementwise_fma(nu, Bv.zw, Ub);
      f32x2 yy2 = __builtin_elementwise_fma(Xb, Rr.zw, Xa * Rr.xy);
      yp[s] = yy2.x + yy2.y;
    }
#undef SCAN_LD
    float ykeep;
    {
      const bool b3 = (cs & 8) != 0, b2 = (cs & 4) != 0, b1 = (cs & 2) != 0, b0 = (cs & 1) != 0;
      float a8[8], a4[4], a2[2];
#pragma unroll
      for (int s = 0; s < 8; s++) { float lo = yp[s], hi = yp[s + 8]; a8[s] = (b3 ? hi : lo) + dpp_get<0x140>(b3 ? lo : hi); }
#pragma unroll
      for (int s = 0; s < 4; s++) { float lo = a8[s], hi = a8[s + 4]; a4[s] = (b2 ? hi : lo) + dpp_get<0x141>(b2 ? lo : hi); }
#pragma unroll
      for (int s = 0; s < 2; s++) { float lo = a4[s], hi = a4[s + 2]; a2[s] = (b1 ? hi : lo) + dpp_get<0x4E>(b1 ? lo : hi); }
      { float lo = a2[0], hi = a2[1]; ykeep = (b0 ? hi : lo) + dpp_get<0xB1>(b0 ? lo : hi); }
    }
    Xa = Xa * g16.xy; Xb = Xb * g16.zw;
    yS[cs * 16 + rl] = ykeep;
    __syncthreads();
    {
      int step = ck * TC + ss; int i = iS + (e ? (T - 1 - step) : step);
      ydst[(size_t)i * 256 + h * 64 + rg * 16 + jj] = f2bf(yS[ss * 16 + jj]);
    }
  }
  __builtin_amdgcn_s_setprio(0);
#undef SCAN_PREFETCH
#undef UNPK
#undef UNPK2
}

#define LOG2E 1.4426950408889634f
#define LN2 0.6931471805599453f

template <bool IS_C>
__device__ __forceinline__ void attn_unit(const Params& p, int layer, int g0, int n, int unit, char* smem, int tid) {
  constexpr int NK = IS_C ? 288 : 192;
  constexpr int NT = IS_C ? 18 : 10;
  constexpr int VS = IS_C ? 304 : 208;
  constexpr int R = IS_C ? 128 : 64;
  bf16_t* Ks = (bf16_t*)smem;
  bf16_t* Vt = Ks + NK * 64;
  const int wave = tid >> 6, lane = tid & 63, fr = lane & 15, fq = lane >> 4;
  int dil, ibase, klo, khi, kcol, vcol, qcol, iq, wst, doff, br = 0, h = 0, hq = 0;
  if (IS_C) {
    int hk = unit & 1, ct = unit >> 1;
    int i0 = ct * 16, g = g0 + i0, s0, T; seqinfo(g, s0, T); int t0 = g - s0;
    dil = 1; ibase = i0 - 128;
    klo = max(0, 128 - t0); khi = min(NK, T - t0 + 128);
    kcol = 1792 + hk * 64; vcol = 1920 + hk * 64;
    hq = hk * 4 + wave; qcol = 1280 + hq * 64; iq = i0 + fr;
    wst = 0; doff = 128;
  } else {
    const int per = n >> 6;
    int bh = unit / per, u = unit - bh * per;
    br = bh >> 2; h = bh & 3;
    dil = br == 0 ? 1 : (br == 1 ? 4 : 16);
    int bidx = u / dil, res = u - bidx * dil;
    int S0 = bidx * 64 * dil, g = g0 + S0, s0, T; seqinfo(g, s0, T); int tS = g - s0;
    int qi0 = tS / dil, L = T / dil;
    ibase = S0 + res - 64 * dil;
    klo = max(0, 64 - qi0); khi = min(NK, L - qi0 + 64);
    kcol = 512 + h * 64; vcol = 768 + h * 64; qcol = 256 + h * 64;
    iq = S0 + res + (wave * 16 + fr) * dil;
    wst = (wave >> 1) * 32; doff = 64 + wave * 16;
  }
#pragma unroll 3
  for (int ch = tid; ch < NK * 8; ch += 256) {
    int key = ch >> 3, c8 = ch & 7;
    bool ok = key >= klo && key < khi;
    u32x4 kv = (u32x4){0u, 0u, 0u, 0u}, vv = (u32x4){0u, 0u, 0u, 0u};
    if (ok) {
      const bf16_t* rowp = p.proj2 + (size_t)(ibase + key * dil) * 2560;
      kv = *(const u32x4*)(rowp + kcol + c8 * 8);
      vv = *(const u32x4*)(rowp + vcol + c8 * 8);
    }
    *(u32x4*)(Ks + key * 64 + ((c8 ^ (key & 7)) * 8)) = kv;
    int pos = (key & ~31) | (((key >> 2) & 3) << 3) | (((key >> 4) & 1) << 2) | (key & 3);
    bf16_t* vd = Vt + (c8 * 8) * VS + pos;
    vd[0 * VS] = (bf16_t)(vv.x & 0xffffu); vd[1 * VS] = (bf16_t)(vv.x >> 16);
    vd[2 * VS] = (bf16_t)(vv.y & 0xffffu); vd[3 * VS] = (bf16_t)(vv.y >> 16);
    vd[4 * VS] = (bf16_t)(vv.z & 0xffffu); vd[5 * VS] = (bf16_t)(vv.z >> 16);
    vd[6 * VS] = (bf16_t)(vv.w & 0xffffu); vd[7 * VS] = (bf16_t)(vv.w >> 16);
  }
  const bf16_t* qrow = p.proj2 + (size_t)iq * 2560 + qcol;
  bf16x8 bq0 = *(const bf16x8*)(qrow + fq * 8);
  bf16x8 bq1 = *(const bf16x8*)(qrow + 32 + fq * 8);
  __syncthreads();
  f32x4 s[NT];
#pragma unroll
  for (int mt = 0; mt < NT; mt++) {
    int key = wst + mt * 16 + fr;
    const bf16_t* kr = Ks + key * 64;
    bf16x8 a0 = *(const bf16x8*)(kr + ((fq ^ (key & 7)) * 8));
    bf16x8 a1 = *(const bf16x8*)(kr + (((4 + fq) ^ (key & 7)) * 8));
    f32x4 acc = (f32x4){0.f, 0.f, 0.f, 0.f};
    acc = __builtin_amdgcn_mfma_f32_16x16x32_bf16(a0, bq0, acc, 0, 0, 0);
    acc = __builtin_amdgcn_mfma_f32_16x16x32_bf16(a1, bq1, acc, 0, 0, 0);
    s[mt] = acc;
  }
  const int lo_c = max(klo, doff + fr - R), hi_c = min(khi - 1, doff + fr + R);
  float mx = -1e30f;
#pragma unroll
  for (int mt = 0; mt < NT; mt++)
#pragma unroll
    for (int j = 0; j < 4; j++) {
      int kap = wst + mt * 16 + fq * 4 + j;
      bool v = kap >= lo_c && kap <= hi_c;
      float sv = v ? s[mt][j] : -1e30f;
      s[mt][j] = sv;
      mx = fmaxf(mx, sv);
    }
  mx = fmaxf(mx, __shfl_xor(mx, 16));
  mx = fmaxf(mx, __shfl_xor(mx, 32));
  float sink2 = 0.f;
  if (IS_C) { sink2 = p.sink[layer * 8 + hq] * LOG2E; mx = fmaxf(mx, sink2); }
  float sum = 0.f;
  unsigned pk[NT / 2][4];
#pragma unroll
  for (int mt = 0; mt < NT; mt++) {
    float p0 = exp2f(s[mt][0] - mx), p1 = exp2f(s[mt][1] - mx), p2 = exp2f(s[mt][2] - mx), p3 = exp2f(s[mt][3] - mx);
    sum += (p0 + p1) + (p2 + p3);
    pk[mt >> 1][(mt & 1) * 2 + 0] = cvt_pk_bf16(p0, p1);
    pk[mt >> 1][(mt & 1) * 2 + 1] = cvt_pk_bf16(p2, p3);
  }
  sum += __shfl_xor(sum, 16);
  sum += __shfl_xor(sum, 32);
  if (IS_C) sum += exp2f(sink2 - mx);
  f32x4 o[4];
#pragma unroll
  for (int dt = 0; dt < 4; dt++) o[dt] = (f32x4){0.f, 0.f, 0.f, 0.f};
#pragma unroll
  for (int u = 0; u < NT / 2; u++) {
    u32x4 pb = (u32x4){pk[u][0], pk[u][1], pk[u][2], pk[u][3]};
    bf16x8 bfrag = __builtin_bit_cast(bf16x8, pb);
#pragma unroll
    for (int dt = 0; dt < 4; dt++) {
      bf16x8 a = *(const bf16x8*)(Vt + (dt * 16 + fr) * VS + wst + u * 32 + fq * 8);
      o[dt] = __builtin_amdgcn_mfma_f32_16x16x32_bf16(a, bfrag, o[dt], 0, 0, 0);
    }
  }
  const float inv = 1.f / sum;
  if (IS_C) {
    const bf16_t* grow = p.proj2 + (size_t)iq * 2560 + 2048 + hq * 64;
    bf16_t* orow = p.Tb + (size_t)iq * 1024 + 512 + hq * 64;
#pragma unroll
    for (int dt = 0; dt < 4; dt++) {
      uint2 gg = *(const uint2*)(grow + dt * 16 + fq * 4);
      float g0f = __uint_as_float(gg.x << 16), g1f = __uint_as_float(gg.x & 0xffff0000u);
      float g2f = __uint_as_float(gg.y << 16), g3f = __uint_as_float(gg.y & 0xffff0000u);
      uint2 ov;
      ov.x = cvt_pk_bf16(o[dt][0] * inv * silu(g0f), o[dt][1] * inv * silu(g1f));
      ov.y = cvt_pk_bf16(o[dt][2] * inv * silu(g2f), o[dt][3] * inv * silu(g3f));
      *(uint2*)(orow + dt * 16 + fq * 4) = ov;
    }
  } else {
    bf16_t* orow = p.obuf + ((size_t)br * n + iq) * 256 + h * 64;
#pragma unroll
    for (int dt = 0; dt < 4; dt++) {
      uint2 ov;
      ov.x = cvt_pk_bf16(o[dt][0] * inv, o[dt][1] * inv);
      ov.y = cvt_pk_bf16(o[dt][2] * inv, o[dt][3] * inv);
      *(uint2*)(orow + dt * 16 + fq * 4) = ov;
    }
    if (fq == 0) p.lse[((size_t)br * n + iq) * 4 + h] = (mx + __log2f(sum)) * LN2;
  }
  __syncthreads();
}

__device__ __forceinline__ void attn_items(const Params& p, int layer, int g0, int n, int first_blk, int nblk, char* smem, int vb) {
  const int TIDX = opaque_tid();
  const int nC = 2 * (n >> 4), nB = 12 * (n >> 6);
  int it = vb - first_blk;
  for (; it < nC; it += nblk) attn_unit<true>(p, layer, g0, n, it, smem, TIDX);
  for (it -= nC; it < nB; it += nblk) attn_unit<false>(p, layer, g0, n, it, smem, TIDX);
}

__device__ __forceinline__ int mix_vb(int nscan_blk) {
  const int G = gridDim.x, half = G >> 1;
  const int b = blockIdx.x;
  if ((G & 1) == 0 && nscan_blk <= half) {
    if (b < nscan_blk) return b;
    return b;
  }
  return b;
}
__device__ __forceinline__ void mix_counts(int g0, int n, int& nP, int& nS, int& gP0, int& gS0) {
  gP0 = g0; int gP1 = min(g0 + n, 32768); nP = gP1 > gP0 ? (gP1 - gP0) / 8192 : 0;
  gS0 = max(g0, 32768); int gS1 = g0 + n; nS = gS1 > gS0 ? (gS1 - gS0) / 16384 : 0;
}
__device__ __forceinline__ void phase_mix(const Params& p, int layer, int g0, int n, char* smem, int iso_lo, int iso_n) {
  int nP, nS, gP0, gS0; mix_counts(g0, n, nP, nS, gP0, gS0);
  const int nitems = (nP + nS) * 32;
  const int nscan_blk = min(nitems, (int)gridDim.x / 2);
  const int vb = mix_vb(nscan_blk);
  if (vb < nscan_blk) {
    for (int it = vb; it < nitems; it += nscan_blk) {
      int sq, rem, iS, T;
      if (it < nS * 32) { sq = it / 32; rem = it % 32; iS = (gS0 - g0) + sq * 16384; T = 16384; }
      else { int j = it - nS * 32; sq = j / 32; rem = j % 32; iS = (gP0 - g0) + sq * 8192; T = 8192; }
      int h = rem >> 3, e = (rem >> 2) & 1, rg = rem & 3;
      __syncthreads();
      scan_item(p, n, iS, T, h, e, rg, smem);
    }
  } else {
    const int b = blockIdx.x;
    if (iso_n > 0) {
      if (b >= iso_lo && b < iso_lo + iso_n) return;
      const int r = (b < iso_lo) ? (b - nscan_blk) : (b - nscan_blk - iso_n);
      attn_items(p, layer, g0, n, 0, gridDim.x - nscan_blk - iso_n, smem, r);
    } else attn_items(p, layer, g0, n, nscan_blk, gridDim.x - nscan_blk, smem, vb);
  }
}

__device__ __forceinline__ float bflo(unsigned w) { return __uint_as_float(w << 16); }
__device__ __forceinline__ float bfhi(unsigned w) { return __uint_as_float(w & 0xffff0000u); }
__device__ __forceinline__ void phase_fina(const Params& p, int layer, int g0, int n, const Rg& rg) {
  const int TIDX = opaque_tid();
  const int h2 = TIDX & 127, c2 = h2 * 2, tsel = TIDX >> 7, head = h2 >> 5;
  const float2 lw = *(const float2*)(p.ln_w + layer * 256 + c2), lb = *(const float2*)(p.ln_b + layer * 256 + c2);
  const bf16_t* Pv = p.PX;
  const int UN = 4;
  for (int i0 = rg.lo + rg.br * (2 * UN); i0 < rg.hi; i0 += rg.nb * (2 * UN)) {
    unsigned yf[UN], yb[UN], pv[UN], ga[UN], gbv[UN], o0[UN], o1[UN], o2[UN];
    float bonv[UN], l0[UN], l1[UN], l2[UN];
#pragma unroll
    for (int u = 0; u < UN; u++) {
      const size_t i = i0 + u * 2 + tsel;
      yf[u] = *(const unsigned*)(p.yf + i * 256 + c2); yb[u] = *(const unsigned*)(p.yb + i * 256 + c2);
      pv[u] = *(const unsigned*)(Pv + i * 256 + c2); bonv[u] = p.bonus[i * 4 + head];
      ga[u] = *(const unsigned*)(p.proj2 + i * 2560 + c2); gbv[u] = *(const unsigned*)(p.proj2 + i * 2560 + 1024 + c2);
      l0[u] = p.lse[((size_t)0 * n + i) * 4 + head]; l1[u] = p.lse[((size_t)1 * n + i) * 4 + head]; l2[u] = p.lse[((size_t)2 * n + i) * 4 + head];
      o0[u] = *(const unsigned*)(p.obuf + ((size_t)0 * n + i) * 256 + c2); o1[u] = *(const unsigned*)(p.obuf + ((size_t)1 * n + i) * 256 + c2);
      o2[u] = *(const unsigned*)(p.obuf + ((size_t)2 * n + i) * 256 + c2);
    }
#pragma unroll
    for (int u = 0; u < UN; u++) {
      const size_t i = i0 + u * 2 + tsel;
      const float y0 = bflo(yf[u]) + bflo(yb[u]), y1 = bfhi(yf[u]) + bfhi(yb[u]);
      float s = red16(y0 + y1); s += __shfl_xor(s, 16);
      const float mean = s * (1.f / 64.f);
      const float d0 = y0 - mean, d1 = y1 - mean;
      float q = red16(d0 * d0 + d1 * d1); q += __shfl_xor(q, 16);
      const float rs = rsqrtf(q * (1.f / 64.f) + 64e-5f);
      const float a0 = (d0 * rs * lw.x + lb.x + bonv[u] * bflo(pv[u])) * silu(bflo(ga[u]));
      const float a1 = (d1 * rs * lw.y + lb.y + bonv[u] * bfhi(pv[u])) * silu(bfhi(ga[u]));
      *(unsigned*)(p.Tb + i * 1024 + c2) = cvt_pk_bf16(a0, a1);
      const float lm = fmaxf(l0[u], fmaxf(l1[u], l2[u]));
      const float e0 = __expf(l0[u] - lm), e1 = __expf(l1[u] - lm), e2 = __expf(l2[u] - lm);
      const float inv = 1.f / (e0 + e1 + e2);
      const float b0 = (e0 * bflo(o0[u]) + e1 * bflo(o1[u]) + e2 * bflo(o2[u])) * inv * silu(bflo(gbv[u]));
      const float b1 = (e0 * bfhi(o0[u]) + e1 * bfhi(o1[u]) + e2 * bfhi(o2[u])) * inv * silu(bfhi(gbv[u]));
      *(unsigned*)(p.Tb + i * 1024 + 256 + c2) = cvt_pk_bf16(b0, b1);
    }
  }
}

__device__ __forceinline__ void phase_fnorm(const Params& p, int g0, const Rg& rg) {
  const int TIDX = opaque_tid();
  int wave = TIDX >> 6, lane = TIDX & 63;
  const float4* gam = (const float4*)p.final_g;
  for (int i = rg.lo + rg.br * 4 + wave; i < rg.hi; i += rg.nb * 4) {
    float4* xr = (float4*)(p.out + (size_t)(g0 + i) * DM);
    float4 v[4]; float ss = 0.f;
#pragma unroll
    for (int q = 0; q < 4; q++) { v[q] = xr[q * 64 + lane]; ss += v[q].x * v[q].x + v[q].y * v[q].y + v[q].z * v[q].z + v[q].w * v[q].w; }
    ss = wave_sum(ss);
    float rstd = rsqrtf(ss * (1.f / 1024.f) + 1e-5f);
#pragma unroll
    for (int q = 0; q < 4; q++) {
      float4 gg = gam[q * 64 + lane];
      float4 o; o.x = v[q].x * rstd * gg.x; o.y = v[q].y * rstd * gg.y; o.z = v[q].z * rstd * gg.z; o.w = v[q].w * rstd * gg.w;
      xr[q * 64 + lane] = o;
    }
  }
}

__global__ void __launch_bounds__(256, 2) mega(Params p, int ph_lo, int ph_hi) {
  __shared__ __attribute__((aligned(16))) char smem[SMEM_BYTES];
  __shared__ uint4 xb_words;
  __shared__ uint4 xb_words2;
  if (threadIdx.x == 0) { xb_words = make_uint4(0u, 0u, 0u, 0u); xb_words2 = make_uint4(0u, 0u, 0u, 0u); }
  __syncthreads();
  const int n = p.ntok_pass;
  int nP, nS, gP0, gS0; mix_counts(0, n, nP, nS, gP0, gS0);
  const int nitems = (nP + nS) * 32;
  const int nscan_blk = min(nitems, (int)gridDim.x / 2);
  const int nsamp = nS * 32;
  const bool overlap = (p.npass == 1) && (nscan_blk == nitems) && nS > 0 && nP > 0 && ((gridDim.x & 7) == 0) && ((nsamp & 7) == 0) && (nsamp <= (nscan_blk >> 1));
  const int vb = mix_vb(nscan_blk);
  const bool sscan = overlap && (vb < nsamp);
  const int snb = (int)gridDim.x - nsamp, srank = vb - nsamp, half_g = (int)gridDim.x >> 1;
  XcdBarrier xb = xcd_barrier_post(p.bar, (volatile LAS unsigned*)&xb_words, gridDim.x, true);
  XcdBarrier xs = xcd_barrier_post(p.bar + 4096, (volatile LAS unsigned*)&xb_words2, (unsigned)snb, overlap && !sscan);
  const int NSTEP = overlap ? 22 : (ph_hi - ph_lo);
  int st0 = 0;
  if (overlap || ph_lo == 0) {
    phase_wconv(p, smem);
    if (overlap) {
      Rg rg; rg.lo = 0; rg.hi = n; rg.br = blockIdx.x; rg.nb = gridDim.x; rg.xb = p.PX; rg.xbase = 0; rg.xr = blockIdx.x >> 3; rg.xn = gridDim.x >> 3;
      phase_xnorm(p, 0, 0, rg);
    }
    if (overlap || 1 < ph_hi) xcd_barrier(xb);
    st0 = overlap ? 2 : 1;
  }
  for (int st = st0; st < NSTEP; st++) {
    int op, layer, rsel, who, bar, g0 = 0, colset = 0;
    if (overlap) {
      switch (st) {
        case 1:  op = 1; layer = 0; rsel = 0; who = 0; bar = 1; break;
        case 2:  op = 2; layer = 0; rsel = 0; who = 0; bar = 1; break;
        case 3:  op = 3; layer = 0; rsel = 0; who = 0; bar = 1; break;
        case 4:  op = 4; layer = 0; rsel = 0; who = 0; bar = 2; break;
        case 5:  op = 5; layer = 0; rsel = 1; who = 1; bar = 2; break;
        case 6:  op = 6; layer = 0; rsel = 1; who = 1; bar = 2; break;
        case 7:  op = 1; layer = 1; rsel = 1; who = 1; bar = 2; break;
        case 8:  op = 2; layer = 1; rsel = 1; who = 1; bar = 1; colset = 1; break;
        case 9:  op = 5; layer = 0; rsel = 2; who = 0; bar = 1; break;
        case 10: op = 6; layer = 0; rsel = 2; who = 0; bar = 1; break;
        case 11: op = 1; layer = 1; rsel = 2; who = 0; bar = 1; break;
        case 12: op = 2; layer = 1; rsel = 2; who = 0; bar = 1; break;
        case 13: op = 3; layer = 1; rsel = 0; who = 0; bar = 1; break;
        case 14: op = 4; layer = 1; rsel = 0; who = 0; bar = 2; break;
        case 15: op = 2; layer = 1; rsel = 1; who = 1; bar = 2; colset = 2; break;
        case 16: op = 5; layer = 1; rsel = 1; who = 1; bar = 2; break;
        case 17: op = 6; layer = 1; rsel = 1; who = 1; bar = 2; break;
        case 18: op = 7; layer = 1; rsel = 1; who = 1; bar = 1; break;
        case 19: op = 5; layer = 1; rsel = 2; who = 0; bar = 1; break;
        case 20: op = 6; layer = 1; rsel = 2; who = 0; bar = 1; break;
        default: op = 7; layer = 1; rsel = 2; who = 0; bar = 0; break;
      }
    } else {
      const int ph = ph_lo + st;
      rsel = 0; who = 0; bar = (ph + 1 < ph_hi) ? 1 : 0; layer = 0;
      if (ph == 0) op = 0;
      else {
        int q = ph - 1, pass = q / 13, r = q % 13;
        g0 = pass * n;
        if (r == 12) op = 7;
        else { layer = r / 6; int s = r % 6; op = (s == 0) ? 1 : (s == 1) ? 2 : (s == 2) ? 3 : (s == 3) ? 4 : (s == 4) ? 5 : 6; }
      }
    }
    const bool iso = overlap && (((st >= 14) && (st <= 18)) || st == 6);
    const bool partner = ((int)blockIdx.x >= half_g) && ((int)blockIdx.x < half_g + nsamp);
    if (!(who == 1 && sscan) && !(iso && partner && who == 1)) {
      Rg rg;
      if (rsel == 0) { rg.lo = 0; rg.hi = n; rg.br = blockIdx.x; rg.nb = gridDim.x; rg.xb = p.PX; rg.xbase = 0; rg.xr = blockIdx.x >> 3; rg.xn = gridDim.x >> 3; }
      else if (rsel == 1) {
        rg.lo = 0; rg.hi = 32768; rg.xb = p.xb2; rg.xbase = 0;
        if (iso) {
          const int bb = (int)blockIdx.x - nsamp - (((int)blockIdx.x >= half_g + nsamp) ? nsamp : 0);
          rg.br = bb; rg.nb = snb - nsamp; rg.xr = bb >> 3; rg.xn = (snb - nsamp) >> 3;
        } else { rg.br = srank; rg.nb = snb; rg.xr = ((int)blockIdx.x - nsamp) >> 3; rg.xn = snb >> 3; }
      }
      else { rg.lo = 32768; rg.hi = n; rg.br = blockIdx.x; rg.nb = gridDim.x; rg.xb = p.obuf; rg.xbase = 32768; rg.xr = blockIdx.x >> 3; rg.xn = gridDim.x >> 3; }
      switch (op) {
        case 1: phase_xnorm(p, layer, g0, rg); break;
        case 2: phase_gemm<0>(p, layer, g0, rg, smem, colset); break;
        case 3: phase_prep(p, layer, g0, n, rg, smem); break;
        case 4: phase_mix(p, layer, g0, n, smem, half_g, iso ? nsamp : 0); break;
        case 5: phase_fina(p, layer, g0, n, rg); break;
        case 6: phase_gemm<1>(p, layer, g0, rg, smem, 0); break;
        default: phase_fnorm(p, g0, rg); break;
      }
    }
    if (bar == 1) { if (ph_hi < 0) cg::this_grid().sync(); else xcd_barrier(xb); }
    else if (bar == 2 && !sscan) xcd_barrier(xs);
  }
}

__global__ void noop_kernel(int* x) { if (x == nullptr && threadIdx.x == 12345) *x = 0; }

extern "C" void kernel_launch(void* const* d_in, const int* in_sizes, int n_in, void* d_out, int out_size, void* d_ws,
                              size_t ws_size, hipStream_t stream) {
  static int grid_blocks = 0;
  if (!grid_blocks) {
    int dev = 0, cus = 0, per_cu = 0;
    hipGetDevice(&dev);
    hipDeviceGetAttribute(&cus, hipDeviceAttributeMultiprocessorCount, dev);
    hipOccupancyMaxActiveBlocksPerMultiprocessor(&per_cu, mega, 256, 0);
    if (per_cu > 2) per_cu = 2;
    if (per_cu < 1) per_cu = 1;
    grid_blocks = (cus * per_cu) & ~7;
  }
  Params p;
  memset((void*)&p, 0, sizeof(p));
  p.xin0 = (const float*)d_in[0]; p.xin1 = (const float*)d_in[1];
  p.norm_g = (const float*)d_in[2]; p.w_in = (const float*)d_in[3]; p.mu = (const float*)d_in[4];
  p.w0 = (const float*)d_in[5]; p.w2 = (const float*)d_in[6]; p.a0 = (const float*)d_in[7]; p.a2 = (const float*)d_in[8];
  p.k_k = (const float*)d_in[9]; p.k_a = (const float*)d_in[10]; p.r_k = (const float*)d_in[11];
  p.ln_w = (const float*)d_in[12]; p.ln_b = (const float*)d_in[13]; p.sink = (const float*)d_in[14];
  p.w_out = (const float*)d_in[15]; p.final_g = (const float*)d_in[16];
  p.out = (float*)d_out;
  auto need = [](size_t n) -> size_t {
    return 32768 + (size_t)2 * 3584 * 1024 * 2 + (size_t)2 * 1024 * 1024 * 2 + n * (2048 + 5120 + 4608 + 2048 + 16 + 1536 + 48) + 8192 + (size_t)16384 * 32 * 8 + 256 + n * 128 + 256 + 2 * 64 * 256 * 8 + 256 + 2 * 4 * 256 * 64 * 2 + 256;
  };
  int npass = (ws_size >= need(NTOK)) ? 1 : 2;
  size_t n = NTOK / npass;
  char* w = (char*)d_ws; size_t off = 0;
  auto take = [&](size_t bytes) { char* r = w + off; off += (bytes + 255) & ~(size_t)255; return r; };
  p.bar = (unsigned*)take(32768);
  p.WinT = (bf16_t*)take((size_t)2 * 3584 * 1024 * 2);
  p.WoutT = (bf16_t*)take((size_t)2 * 1024 * 1024 * 2);
  p.Tb = (bf16_t*)take(n * 2048);
  p.proj2 = (bf16_t*)take(n * 5120);
  p.PX = (bf16_t*)take(n * 4608);
  p.yf = (bf16_t*)take(n * 512);
  p.yb = (bf16_t*)take(n * 512);
  p.xb2 = (bf16_t*)take(n * 1024);
  p.bonus = (float*)take(n * 16);
  p.obuf = (bf16_t*)take(n * 1536);
  p.lse = (float*)take(n * 48);
  p.ropetab = (float2*)take((size_t)16384 * 32 * 8);
  p.g16 = (float*)take(n / 16 * 512 * 4);
  p.lw = (uint2*)take((size_t)2 * 64 * 256 * 8);
  p.lwT = (bf16_t*)take((size_t)2 * 4 * 256 * 64 * 2);
  p.npass = npass; p.ntok_pass = (int)n;
  const int nph = 1 + 13 * npass;
  hipMemsetAsync(p.bar, 0, 32768, stream);
  int ph_lo = 0, ph_hi = nph;
  void* args[] = {(void*)&p, (void*)&ph_lo, (void*)&ph_hi};
  hipError_t e = hipLaunchCooperativeKernel((const void*)mega, dim3(grid_blocks), dim3(256), args, 0, stream);
  if (e != hipSuccess) fprintf(stderr, "cooperative launch failed: %s (grid %d)\n", hipGetErrorString(e), grid_blocks);
}
```

```cpp
#include <hip/hip_runtime.h>
#include <hip/hip_cooperative_groups.h>
#include <stdint.h>
#include <stdio.h>
#include <string.h>
namespace cg = cooperative_groups;

typedef unsigned short bf16_t;
using bf16x8 = __attribute__((ext_vector_type(8))) short;
using f32x4 = __attribute__((ext_vector_type(4))) float;
using u32x4 = __attribute__((ext_vector_type(4))) unsigned int;
using f32x2 = __attribute__((ext_vector_type(2))) float;

#define NTOK 65536
#ifndef DUP
#define DUP -1
#endif
#define DM 1024
#define SMEM_BYTES 75776

__device__ __forceinline__ float bf2f(bf16_t h) { return __uint_as_float(((unsigned)h) << 16); }
__device__ __forceinline__ unsigned cvt_pk_bf16(float lo, float hi) {
  unsigned r; asm("v_cvt_pk_bf16_f32 %0,%1,%2" : "=v"(r) : "v"(lo), "v"(hi)); return r;
}
__device__ __forceinline__ bf16_t f2bf(float f) { return (bf16_t)cvt_pk_bf16(f, f); }
__device__ __forceinline__ unsigned pack2(float a, float b) { return cvt_pk_bf16(a, b); }
__device__ __forceinline__ float wave_sum(float v) {
#pragma unroll
  for (int o = 32; o > 0; o >>= 1) v += __shfl_xor(v, o);
  return v;
}
__device__ __forceinline__ float wave_max(float v) {
#pragma unroll
  for (int o = 32; o > 0; o >>= 1) v = fmaxf(v, __shfl_xor(v, o));
  return v;
}
template <int CTRL>
__device__ __forceinline__ float dpp_add(float x) {
  int y = __builtin_amdgcn_update_dpp(0, __float_as_int(x), CTRL, 0xf, 0xf, true);
  return x + __int_as_float(y);
}
template <int CTRL>
__device__ __forceinline__ float dpp_get(float x) {
  return __int_as_float(__builtin_amdgcn_update_dpp(0, __float_as_int(x), CTRL, 0xf, 0xf, true));
}
__device__ __forceinline__ float red16(float x) {
  x = dpp_add<0xB1>(x);
  x = dpp_add<0x4E>(x);
  x = dpp_add<0x141>(x);
  x = dpp_add<0x140>(x);
  return x;
}
__device__ __forceinline__ float xrow16_sum(float v) {
  unsigned x = __float_as_uint(v);
  auto r = __builtin_amdgcn_permlane16_swap(x, x, false, false);
  return __uint_as_float(r[0]) + __uint_as_float(r[1]);
}
__device__ __forceinline__ float xrow32_sum(float v) {
  unsigned x = __float_as_uint(v);
  auto r = __builtin_amdgcn_permlane32_swap(x, x, false, false);
  return __uint_as_float(r[0]) + __uint_as_float(r[1]);
}
__device__ __forceinline__ float wave_sum_fast(float v) {
  v = red16(v);
  v = xrow16_sum(v);
  v = xrow32_sum(v);
  return v;
}
__device__ __forceinline__ int opaque_tid() { int t = threadIdx.x; asm volatile("" : "+v"(t)); return t; }
__device__ __forceinline__ float silu(float g) { return g / (1.f + __expf(-g)); }

#define XB_TMO      128
#define XB_XCNT(j)  (256  + 64 * (j))
#define XB_XSUB(j)  (1280 + 64 * (j))
#define XB_XGEN(j)  (2304 + 64 * (j))
#define XB_TOP      3328
#define XB_TOPGEN   3392
#define XCD_BAR_WORDS 3456
#define XB_SPIN_CAP (1u << 18)
#define LAS __attribute__((address_space(3)))

__device__ __forceinline__ unsigned xb_ld(unsigned* p)              { return __hip_atomic_load(p, __ATOMIC_RELAXED, __HIP_MEMORY_SCOPE_AGENT); }
__device__ __forceinline__ unsigned xb_add(unsigned* p, unsigned v) { return __hip_atomic_fetch_add(p, v, __ATOMIC_RELAXED, __HIP_MEMORY_SCOPE_AGENT); }
__device__ __forceinline__ unsigned xb_xcc_id() { return (unsigned)__builtin_amdgcn_s_getreg((3 << 11) | 20) & 0xFu; }
#define XB_SPIN(cond, bar) do { unsigned _sp = 0; while (cond) { __builtin_amdgcn_s_sleep(1); \
    if ((++_sp & 255u) == 0u) { if (xb_ld(&(bar)[XB_TMO])) break; if (_sp > XB_SPIN_CAP) { atomicAdd(&(bar)[XB_TMO], 1u); break; } } } } while (0)

struct XcdBarrier {
    unsigned total;
    unsigned* bar; unsigned x;
    volatile LAS unsigned* st;
};

__device__ __forceinline__ XcdBarrier xcd_barrier_post(unsigned* bar, volatile LAS unsigned* st, unsigned total, bool member) {
    XcdBarrier b; b.total = total; b.bar = bar; b.x = xb_xcc_id(); b.st = st;
    if (threadIdx.x == 0 && member) (void)xb_add(&bar[XB_XCNT(b.x)], 1u);
    return b;
}
__device__ __forceinline__ void xcd_barrier_complete(unsigned* bar, unsigned x, unsigned& nloc, unsigned& nx, unsigned G) {
    unsigned sum, cnt, mine, sp = 0u;
    for (;;) {
        sum = 0u; cnt = 0u; mine = 0u;
#pragma unroll
        for (unsigned j = 0; j < 16; ++j) { const unsigned c = xb_ld(&bar[XB_XCNT(j)]); sum += c; cnt += (c > 0u) ? 1u : 0u; mine = (j == x) ? c : mine; }
        if (sum == G) break;
        __builtin_amdgcn_s_sleep(1);
        if ((++sp & 255u) == 0u) { if (xb_ld(&bar[XB_TMO])) break; if (sp > XB_SPIN_CAP) { atomicAdd(&bar[XB_TMO], 1u); break; } }
    }
    nloc = mine > 0u ? mine : 1u; nx = cnt > 0u ? cnt : 1u;
}

__device__ __forceinline__ void xcd_barrier(const XcdBarrier& b) {
    asm volatile("s_waitcnt vmcnt(0)" ::: "memory");
    __syncthreads();
    if (threadIdx.x == 0) {
        unsigned* bar = b.bar;
        __builtin_amdgcn_s_waitcnt(0);
        unsigned nloc = b.st[0], nx = b.st[1];
        if (nloc == 0u) { xcd_barrier_complete(bar, b.x, nloc, nx, b.total); b.st[0] = nloc; b.st[1] = nx; }
        const unsigned old = xb_add(&bar[XB_XSUB(b.x)], 1u);
        const unsigned gen = old / nloc;
        if (old + 1u == (gen + 1u) * nloc) {
            __builtin_amdgcn_fence(__ATOMIC_RELEASE, "agent");
            asm volatile("s_waitcnt vmcnt(0)" ::: "memory");
            const unsigned og = xb_add(&bar[XB_TOP], 1u);
            const unsigned tg = og / nx;
            if (og + 1u == (tg + 1u) * nx) xb_add(&bar[XB_TOPGEN], 1u);
            else XB_SPIN(xb_ld(&bar[XB_TOPGEN]) == tg, bar);
            __builtin_amdgcn_fence(__ATOMIC_ACQUIRE, "agent");
            xb_add(&bar[XB_XGEN(b.x)], 1u);
            asm volatile("s_waitcnt vmcnt(0)" ::: "memory");
        } else {
            XB_SPIN(xb_ld(&bar[XB_XGEN(b.x)]) == gen, bar);
            __builtin_amdgcn_fence(__ATOMIC_ACQUIRE, "agent");
            asm volatile("s_waitcnt vmcnt(0)" ::: "memory");
        }
    }
    __syncthreads();
}


struct Params {
  const float* xin0; const float* xin1;
  const float* norm_g; const float* w_in; const float* mu; const float* w0; const float* w2; const float* a0;
  const float* a2; const float* k_k; const float* k_a; const float* r_k; const float* ln_w; const float* ln_b;
  const float* sink; const float* w_out; const float* final_g;
  float* out;
  bf16_t* WinT; bf16_t* WoutT;
  bf16_t* Tb; bf16_t* proj2; bf16_t* PX;
  bf16_t* yf; bf16_t* yb; float* bonus; bf16_t* xb2;
  bf16_t* obuf; float* lse; float2* ropetab; float* g16; uint2* lw; bf16_t* lwT;
  unsigned* bar;
  int npass; int ntok_pass;
};

struct Rg { int lo, hi, br, nb; bf16_t* xb; int xbase; int xr, xn; };
__device__ __forceinline__ void seqinfo(int g, int& s0, int& T) {
  if (g < 32768) { T = 8192; s0 = g & ~8191; } else { T = 16384; s0 = g & ~16383; }
}
__device__ __forceinline__ const float* xrow(const Params& p, int g) {
  return g < 32768 ? p.xin0 + (size_t)g * DM : p.xin1 + (size_t)(g - 32768) * DM;
}

__device__ __forceinline__ void phase_wconv(const Params& p, char* smem) {
  const int TIDX = opaque_tid();
  for (int idx = blockIdx.x * 256 + TIDX; idx < 2 * 64 * 256; idx += gridDim.x * 256) {
    int layer = idx >> 14, l = (idx >> 8) & 63, cc = idx & 255;
    size_t of = (size_t)((layer * 2 + 0) * 64 + l) * 256 + cc, ob = (size_t)((layer * 2 + 1) * 64 + l) * 256 + cc;
    uint2 o; o.x = pack2(p.w2[of], p.w2[ob]); o.y = pack2(p.a2[of], p.a2[ob]);
    p.lw[idx] = o;
  }
  for (int idx = blockIdx.x * 256 + TIDX; idx < 2 * 4 * 256 * 64; idx += gridDim.x * 256) {
    int l = idx & 63, cc = (idx >> 6) & 255, g = (idx >> 14) & 3, layer = idx >> 16;
    const float* srcw = (g < 2) ? p.w2 : p.a2;
    p.lwT[idx] = f2bf(srcw[(size_t)((layer * 2 + (g & 1)) * 64 + l) * 256 + cc]);
  }
  for (int idx = blockIdx.x * 256 + TIDX; idx < 16384 * 32; idx += gridDim.x * 256) {
    int t = idx >> 5, fi = idx & 31;
    double inv = exp2(-(double)fi * (13.287712379549449 / 32.0));
    double ang = (double)t * inv;
    double sn, cs; sincos(ang, &sn, &cs);
    p.ropetab[idx] = make_float2((float)cs, (float)sn);
  }
  float (*tile)[65] = (float (*)[65])smem;
  const int per_layer = 16 * 56 + 16 * 16;
  for (int it = blockIdx.x; it < 2 * per_layer; it += gridDim.x) {
    int l = it / per_layer, r = it % per_layer;
    const float* src; bf16_t* dst; int N, kt, nt;
    if (r < 896) { kt = r / 56; nt = r % 56; src = p.w_in + (size_t)l * 1024 * 3584; dst = p.WinT + (size_t)l * 3584 * 1024; N = 3584; }
    else { r -= 896; kt = r / 16; nt = r % 16; src = p.w_out + (size_t)l * 1024 * 1024; dst = p.WoutT + (size_t)l * 1024 * 1024; N = 1024; }
    for (int e = TIDX; e < 4096; e += 256) { int i = e >> 6, j = e & 63; tile[i][j] = src[(size_t)(kt * 64 + i) * N + nt * 64 + j]; }
    __syncthreads();
    for (int e = TIDX; e < 4096; e += 256) { int j = e >> 6, i = e & 63; dst[(size_t)(nt * 64 + j) * 1024 + kt * 64 + i] = f2bf(tile[i][j]); }
    __syncthreads();
  }
}

__device__ __forceinline__ void phase_xnorm(const Params& p, int layer, int g0, const Rg& rg) {
  const int TIDX = opaque_tid();
  int wave = TIDX >> 6, lane = TIDX & 63;
  const float4* gam = (const float4*)(p.norm_g + layer * 1024);
  const int stride = rg.nb * 4;
  for (int ia = rg.lo + rg.br * 4 + wave; ia < rg.hi; ia += 2 * stride) {
    const int ib = ia + stride; const bool hb = ib < rg.hi;
    const float4* xa = (const float4*)((layer == 0) ? xrow(p, g0 + ia) : (p.out + (size_t)(g0 + ia) * DM));
    const float4* xb = (const float4*)((layer == 0) ? xrow(p, g0 + (hb ? ib : ia)) : (p.out + (size_t)(g0 + (hb ? ib : ia)) * DM));
    float4 va[4], vb[4]; float sa = 0.f, sb = 0.f;
#pragma unroll
    for (int q = 0; q < 4; q++) { va[q] = xa[q * 64 + lane]; vb[q] = xb[q * 64 + lane]; }
#pragma unroll
    for (int q = 0; q < 4; q++) {
      sa += va[q].x * va[q].x + va[q].y * va[q].y + va[q].z * va[q].z + va[q].w * va[q].w;
      sb += vb[q].x * vb[q].x + vb[q].y * vb[q].y + vb[q].z * vb[q].z + vb[q].w * vb[q].w;
    }
    sa = wave_sum_fast(sa); sb = wave_sum_fast(sb);
    float ra = rsqrtf(sa * (1.f / 1024.f) + 1e-5f), rb = rsqrtf(sb * (1.f / 1024.f) + 1e-5f);
    uint2* da = (uint2*)(rg.xb + (size_t)(ia - rg.xbase) * 1024);
    uint2* db = (uint2*)(rg.xb + (size_t)(ib - rg.xbase) * 1024);
#pragma unroll
    for (int q = 0; q < 4; q++) {
      float4 gg = gam[q * 64 + lane];
      uint2 o; o.x = pack2(va[q].x * ra * gg.x, va[q].y * ra * gg.y); o.y = pack2(va[q].z * ra * gg.z, va[q].w * ra * gg.w);
      da[q * 64 + lane] = o;
      if (hb) { uint2 o2; o2.x = pack2(vb[q].x * rb * gg.x, vb[q].y * rb * gg.y); o2.y = pack2(vb[q].z * rb * gg.z, vb[q].w * rb * gg.w); db[q * 64 + lane] = o2; }
    }
  }
}

template <int MODE>
__device__ __forceinline__ void phase_gemm(const Params& p, int layer, int g0, const Rg& rg, char* smem, int colset) {
  const int TIDX = opaque_tid();
  const int tid = TIDX, wave = tid >> 6, lane = tid & 63, wm = wave >> 1, wn = wave & 1, fr = lane & 15, fq = lane >> 4;
  const int NT = (MODE == 0) ? 28 : 8;
  const bf16_t* A = (MODE == 0) ? rg.xb : p.Tb;
  const int abase = (MODE == 0) ? rg.xbase : 0;
  const bf16_t* Bt = (MODE == 0) ? (p.WinT + (size_t)layer * 3584 * 1024) : (p.WoutT + (size_t)layer * 1024 * 1024);
  const int xcd = blockIdx.x & 7, rgp = xcd >> 2, cgp = xcd & 3;
  const int tm0 = rg.lo >> 8, ntmh = (rg.hi - rg.lo) >> 9;
  const int cpg = (MODE == 0) ? (colset == 0 ? 7 : (colset == 1 ? 6 : 1)) : 2;
  const int nloc = ntmh * cpg;
  for (int q = rg.xr; q < nloc; q += rg.xn) {
    const int tm = tm0 + rgp * ntmh + q / cpg;
    const int tni = cgp * cpg + q % cpg;
    int tn = tni;
    if (MODE == 0 && colset == 1) tn = (tni < 8) ? tni : ((tni < 14) ? tni + 2 : tni + 4);
    if (MODE == 0 && colset == 2) tn = (tni < 2) ? 8 + tni : 14 + tni;
    const bf16_t* Ag = A + (size_t)(tm * 256 - abase) * 1024;
    const bf16_t* Bg = Bt + (size_t)(tn * 128) * 1024;
    f32x4 acc[8][4];
#pragma unroll
    for (int a = 0; a < 8; a++)
#pragma unroll
      for (int b = 0; b < 4; b++) acc[a][b] = (f32x4){0.f, 0.f, 0.f, 0.f};
    const int g_r = lane >> 2, g_c = (lane & 3) * 8;
#define G_GLDS(BUF, K0) { char* As_ = smem + (BUF) * 24576; char* Bs_ = As_ + 16384; \
      _Pragma("unroll") for (int i = 0; i < 4; i++) { const int rr = (wave + i * 4) * 16 + g_r; \
      __builtin_amdgcn_global_load_lds((const unsigned*)(Ag + (size_t)rr * 1024 + (K0) + g_c), (LAS unsigned*)(As_ + (wave + i * 4) * 1024), 16, 0, 0); } \
      _Pragma("unroll") for (int i = 0; i < 2; i++) { const int rr = (wave + i * 4) * 16 + g_r; \
      __builtin_amdgcn_global_load_lds((const unsigned*)(Bg + (size_t)rr * 1024 + (K0) + g_c), (LAS unsigned*)(Bs_ + (wave + i * 4) * 1024), 16, 0, 0); } }
    asm volatile("s_waitcnt vmcnt(0)" ::: "memory");
    G_GLDS(0, 0);
    G_GLDS(1, 32);
    int cur = 0;
    for (int kt = 0; kt < 32; kt++) {
      if (kt < 31) asm volatile("s_waitcnt vmcnt(6)\n\ts_waitcnt lgkmcnt(0)\n\ts_barrier" ::: "memory");
      else asm volatile("s_waitcnt vmcnt(0)\n\ts_waitcnt lgkmcnt(0)\n\ts_barrier" ::: "memory");
      const int nxt2 = (cur == 0) ? 2 : cur - 1;
      const bf16_t* Ac = (const bf16_t*)(smem + cur * 24576);
      const bf16_t* Bc = Ac + 8192;
      bf16x8 af[8], bfr[4];
#pragma unroll
      for (int nt = 0; nt < 4; nt++) bfr[nt] = *(const bf16x8*)(Bc + (wn * 64 + nt * 16 + fr) * 32 + fq * 8);
#pragma unroll
      for (int mt = 7; mt >= 0; mt--) af[mt] = *(const bf16x8*)(Ac + (wm * 128 + mt * 16 + fr) * 32 + fq * 8);
      __builtin_amdgcn_sched_barrier(0);
#pragma unroll
      for (int mt = 0; mt < 8; mt++)
#pragma unroll
        for (int nt = 0; nt < 4; nt++)
          acc[mt][nt] = __builtin_amdgcn_mfma_f32_16x16x32_bf16(bfr[nt], af[mt], acc[mt][nt], 0, 0, 0);
      __builtin_amdgcn_sched_barrier(0);
      if (kt + 2 < 32) G_GLDS(nxt2, (kt + 2) * 32);
      cur = (cur == 2) ? 0 : cur + 1;
    }
    asm volatile("s_waitcnt lgkmcnt(0)\n\ts_barrier" ::: "memory");
#undef G_GLDS
    if (MODE == 0) {
      const int hc = tn * 128 + wn * 64;
      const bool rope = (hc >= 1280 && hc < 1792) || (hc >= 2304 && hc < 2944);
      const float sc = ((hc >= 1280 && hc < 1536) || (hc >= 2304 && hc < 2816)) ? (0.125f * 1.4426950408889634f) : 1.f;
#pragma unroll
      for (int mt = 0; mt < 8; mt++) {
        const int i = tm * 256 + wm * 128 + mt * 16 + fr;
        if (rope) {
          int g = g0 + i, s0, T; seqinfo(g, s0, T); const int t = g - s0;
          const float2* tab = p.ropetab + (size_t)t * 32;
#pragma unroll
          for (int nt = 0; nt < 2; nt++) {
            const float4 cs01 = *(const float4*)(tab + nt * 16 + fq * 4);
            const float4 cs23 = *(const float4*)(tab + nt * 16 + fq * 4 + 2);
            const float cc[4] = {cs01.x, cs01.z, cs23.x, cs23.z};
            const float ss[4] = {cs01.y, cs01.w, cs23.y, cs23.w};
#pragma unroll
            for (int j = 0; j < 4; j++) {
              float x1 = acc[mt][nt][j], x2 = acc[mt][nt + 2][j];
              acc[mt][nt][j] = (x1 * cc[j] - x2 * ss[j]) * sc;
              acc[mt][nt + 2][j] = (x2 * cc[j] + x1 * ss[j]) * sc;
            }
          }
        }
        char* strow = smem + (wm * 128 + mt * 16 + fr) * 272 + (wn * 64 + fq * 4) * 2;
#pragma unroll
        for (int nt = 0; nt < 4; nt++) {
          uint2 o; o.x = cvt_pk_bf16(acc[mt][nt][0], acc[mt][nt][1]); o.y = cvt_pk_bf16(acc[mt][nt][2], acc[mt][nt][3]);
          *(uint2*)(strow + nt * 32) = o;
        }
      }
      __syncthreads();
      {
        const int col0 = tn * 128;
        bf16_t* base; size_t stride;
        if (col0 < 1024) { base = p.Tb + col0; stride = 1024; } else { base = p.proj2 + (col0 - 1024); stride = 2560; }
        const int c16 = tid & 15, r0 = tid >> 4;
#pragma unroll
        for (int i = 0; i < 16; i++) {
          const int row = r0 + i * 16;
          u32x4 v = *(const u32x4*)(smem + row * 272 + c16 * 16);
          *(u32x4*)(base + (size_t)(tm * 256 + row) * stride + c16 * 8) = v;
        }
      }
      __syncthreads();
    } else {
#pragma unroll
      for (int mt = 0; mt < 8; mt++) {
        const int i = tm * 256 + wm * 128 + mt * 16 + fr, g = g0 + i;
        const int col0 = tn * 128 + wn * 64;
        const float* xr = (layer == 0) ? (xrow(p, g) + col0) : (p.out + (size_t)g * DM + col0);
        float* orow = p.out + (size_t)g * DM + col0;
#pragma unroll
        for (int nt = 0; nt < 4; nt++) {
          float4 xv = *(const float4*)(xr + nt * 16 + fq * 4);
          float4 o; o.x = xv.x + acc[mt][nt][0]; o.y = xv.y + acc[mt][nt][1]; o.z = xv.z + acc[mt][nt][2]; o.w = xv.w + acc[mt][nt][3];
          *(float4*)(orow + nt * 16 + fq * 4) = o;
        }
      }
    }
  }
}

__device__ __forceinline__ float shiftv(const bf16_t* tb, int r, int col, float mu) {
  float f = bf2f(tb[(r + 1) * 1024 + col]);
  float pv = bf2f(tb[r * 1024 + col]);
  float nx = bf2f(tb[(r + 2) * 1024 + col]);
  return f + mu * (0.5f * (pv + nx) - f);
}

__device__ __forceinline__ void phase_prep(const Params& p, int layer, int g0, int n, const Rg& rg, char* smem) {
  const int TIDX = opaque_tid();
  bf16_t* linb = (bf16_t*)smem;
  float* zbuf = (float*)(smem + 8704);
  bf16_t* tb = (bf16_t*)(smem + 8704 + 16640);
  const int TT = 16;
  const int c = TIDX, wave = c >> 6;
  const float* mu = p.mu + layer * 1024;
  const float mu_r = mu[c], mu_k = mu[256 + c], mu_v = mu[512 + c], mu_l = mu[768 + c];
  const float kkc = p.k_k[layer * 256 + c], kac = p.k_a[layer * 256 + c], rkc = p.r_k[layer * 256 + c];
  const float w0f = p.w0[(layer * 2 + 0) * 256 + c], w0b = p.w0[(layer * 2 + 1) * 256 + c];
  const float a0f = p.a0[(layer * 2 + 0) * 256 + c], a0b = p.a0[(layer * 2 + 1) * 256 + c];
  const uint2* lwp = p.lw + (size_t)layer * 64 * 256 + c;
  const float* w2f = p.w2 + (size_t)((layer * 2 + 0) * 64) * 256 + c;
  const float* w2b = p.w2 + (size_t)((layer * 2 + 1) * 64) * 256 + c;
  const float* a2f = p.a2 + (size_t)((layer * 2 + 0) * 64) * 256 + c;
  const float* a2b = p.a2 + (size_t)((layer * 2 + 1) * 64) * 256 + c;
  const size_t PS = (size_t)n * 256;
  bf16_t* Pv = p.PX;
  for (int tile = (rg.lo >> 4) + rg.br; tile < (rg.hi >> 4); tile += rg.nb) {
    const int i0 = tile * TT;
    {
      int g = g0 + i0, s0, T; seqinfo(g, s0, T); int t0 = g - s0;
#pragma unroll
      for (int q = 0; q < 9; q++) {
        int ch = c + q * 256;
        int r = ch >> 7, cc = ch & 127;
        int t = t0 - 1 + r;
        u32x4 v = (u32x4){0u, 0u, 0u, 0u};
        if (t >= 0 && t < T) v = *(const u32x4*)(p.Tb + (size_t)(i0 - 1 + r) * 1024 + cc * 8);
        *(u32x4*)(tb + r * 1024 + cc * 8) = v;
      }
    }
    __syncthreads();
#pragma unroll 4
    for (int tk = 0; tk < TT; tk++) {
      float sh = shiftv(tb, tk, 768 + c, mu_l);
      if (c < 128) { float e2 = __expf(2.f * sh); sh = 1.f - 2.f / (e2 + 1.f); }
      linb[tk * 272 + c] = f2bf(sh);
    }
    __syncthreads();
    float zwf[TT], zwb[TT], zaf[TT], zab[TT];
#pragma unroll
    for (int tk = 0; tk < TT; tk++) { zwf[tk] = w0f; zwb[tk] = w0b; zaf[tk] = a0f; zab[tk] = a0b; }
    {
      const int lane = c & 63, fr = lane & 15, fq = lane >> 4;
#pragma unroll
      for (int gq = 0; gq < 4; gq++) {
        f32x4 acc[4];
#pragma unroll
        for (int nt = 0; nt < 4; nt++) acc[nt] = (f32x4){0.f, 0.f, 0.f, 0.f};
#pragma unroll
        for (int ks = 0; ks < 2; ks++) {
          bf16x8 av = *(const bf16x8*)(linb + fr * 272 + gq * 64 + ks * 32 + fq * 8);
#pragma unroll
          for (int nt = 0; nt < 4; nt++) {
            bf16x8 bv = *(const bf16x8*)(p.lwT + ((size_t)((layer * 4 + gq) * 256 + wave * 64 + nt * 16 + fr)) * 64 + ks * 32 + fq * 8);
            acc[nt] = __builtin_amdgcn_mfma_f32_16x16x32_bf16(av, bv, acc[nt], 0, 0, 0);
          }
        }
#pragma unroll
        for (int nt = 0; nt < 4; nt++)
#pragma unroll
          for (int jx = 0; jx < 4; jx++) zbuf[(fq * 4 + jx) * 260 + wave * 64 + nt * 16 + fr] = acc[nt][jx];
        __syncthreads();
#pragma unroll
        for (int tk = 0; tk < TT; tk++) {
          float zv = zbuf[tk * 260 + c];
          if (gq == 0) zwf[tk] += zv; else if (gq == 1) zwb[tk] += zv; else if (gq == 2) zaf[tk] += zv; else zab[tk] += zv;
        }
        __syncthreads();
      }
    }
    float gf[TT], gb[TT];
#pragma unroll
    for (int tk = 0; tk < TT; tk++) {
#pragma unroll
      for (int e = 0; e < 2; e++) {
        float nz = -(e ? zwb[tk] : zwf[tk]);
        float sp = fmaxf(nz, 0.f) + __logf(1.f + __expf(-fabsf(nz)));
        float dec = __expf(-__expf(-sp - 0.5f));
        if (e) gb[tk] = dec; else gf[tk] = dec;
      }
    }
#pragma unroll
    for (int tk = 1; tk < TT; tk++) gf[tk] *= gf[tk - 1];
#pragma unroll
    for (int tk = TT - 2; tk >= 0; tk--) gb[tk] *= gb[tk + 1];
    p.g16[(size_t)tile * 512 + c] = gf[TT - 1];
    p.g16[(size_t)tile * 512 + 256 + c] = gb[0];
#pragma unroll
    for (int tk = 0; tk < TT; tk++) {
      int i = i0 + tk;
      float r = shiftv(tb, tk, c, mu_r);
      float k = shiftv(tb, tk, 256 + c, mu_k);
      float v = shiftv(tb, tk, 512 + c, mu_v);
      float kk = k * kkc;
      float ss = wave_sum_fast(kk * kk);
      kk = kk / fmaxf(sqrtf(ss), 1e-12f);
      float keffsum = 0.f;
#pragma unroll
      for (int e = 0; e < 2; e++) {
        float za = e ? zab[tk] : zaf[tk];
        float a = 1.f / (1.f + __expf(-za));
        float keff = k * (1.f + (a - 1.f) * kac);
        float b = kk * a;
        keffsum += keff;
        float gcur = e ? gb[tk] : gf[tk];
        float gprev = e ? (tk < TT - 1 ? gb[tk + 1] : 1.f) : (tk > 0 ? gf[tk - 1] : 1.f);
        float ginv = 1.f / gcur;
        unsigned* b32 = (unsigned*)(p.PX + (size_t)(1 + 4 * e) * PS);
        b32[(size_t)i * 256 + c] = cvt_pk_bf16(kk * gprev, r * gcur);
        b32[PS + (size_t)i * 256 + c] = cvt_pk_bf16(keff * ginv, b * ginv);
      }
      float bon = wave_sum_fast(r * keffsum * rkc);
      if ((c & 63) == 0) p.bonus[i * 4 + wave] = bon;
      Pv[(size_t)i * 256 + c] = f2bf(v);
    }
    __syncthreads();
  }
}

__device__ __forceinline__ void scan_item(const Params& p, int n, int iS, int T, int h, int e, int rg, char* smem) {
  const int TIDX = opaque_tid();
  const int TC = 16, RS = 256, BUFS = TC * 256 + 256;
  float* buf = (float*)smem;
  float* yS = buf + 2 * BUFS;
  const int tid = TIDX, wave = tid >> 6, lane = tid & 63, rl = wave * 4 + (lane >> 4), cs = lane & 15;
  const size_t PS = (size_t)n * 256;
  const bf16_t* Pv = p.PX;
  const unsigned* PAR = (const unsigned*)(p.PX + (size_t)(1 + 4 * e) * PS); const unsigned* PKB = PAR + PS;
  bf16_t* ydst = e ? p.yb : p.yf;
  const int nch = T / TC;
  const int ss = tid >> 4, jj = tid & 15;
  u32x4 rAR, rKB; bf16_t rv; f32x4 g16n;
#define SCAN_PREFETCH(CK) { int step = (CK) * TC + ss; int i = iS + (e ? (T - 1 - step) : step); \
    size_t o = (size_t)i * 256 + h * 64 + jj * 4; \
    rAR = *(const u32x4*)(PAR + o); rKB = *(const u32x4*)(PKB + o); \
    rv = Pv[(size_t)i * 256 + h * 64 + rg * 16 + jj]; \
    int tl = (iS + (e ? (T - TC * ((CK) + 1)) : (CK) * TC)) >> 4; \
    g16n = *(const f32x4*)(p.g16 + (size_t)tl * 512 + e * 256 + h * 64 + cs * 4); }
#define UNPK2(dst, src, OLO, OHI) { float4 f, g_; f.x = __uint_as_float(src.x << 16); f.y = __uint_as_float(src.y << 16); \
    f.z = __uint_as_float(src.z << 16); f.w = __uint_as_float(src.w << 16); \
    g_.x = __uint_as_float(src.x & 0xffff0000u); g_.y = __uint_as_float(src.y & 0xffff0000u); \
    g_.z = __uint_as_float(src.z & 0xffff0000u); g_.w = __uint_as_float(src.w & 0xffff0000u); \
    *(float4*)(dst + OLO + jj * 4) = f; *(float4*)(dst + OHI + jj * 4) = g_; }
#define UNPK(dst, src, OFS) { float4 f; f.x = __uint_as_float(src.x << 16); f.y = __uint_as_float(src.x & 0xffff0000u); \
    f.z = __uint_as_float(src.y << 16); f.w = __uint_as_float(src.y & 0xffff0000u); *(float4*)(dst + OFS + jj * 4) = f; }
  SCAN_PREFETCH(0);
  if (T > 8192) __builtin_amdgcn_s_setprio(3); else __builtin_amdgcn_s_setprio(2);
  f32x2 Xa = (f32x2){0.f, 0.f}, Xb = (f32x2){0.f, 0.f};
  for (int ck = 0; ck < nch; ck++) {
    float* B = buf + (ck & 1) * BUFS;
    {
      float* q = B + ss * RS;
      UNPK2(q, rAR, 0, 64);
      UNPK2(q, rKB, 128, 192);
      B[TC * 256 + jj * 16 + ss] = bf2f(rv);
    }
    const f32x4 g16 = g16n;
    __syncthreads();
    if (ck + 1 < nch) SCAN_PREFETCH(ck + 1);
    float yp[TC];
    f32x4 Aq[3], Rq[3], Kq[3], Bq[3];
    f32x4 v4[4];
#pragma unroll
    for (int q4 = 0; q4 < 4; q4++) v4[q4] = *(const f32x4*)(B + TC * 256 + rl * 16 + q4 * 4);
#define SCAN_LD(S) { const float* q_ = B + (S) * 256; Aq[(S) % 3] = *(const f32x4*)(q_ + cs * 4); Rq[(S) % 3] = *(const f32x4*)(q_ + 64 + cs * 4); \
      Kq[(S) % 3] = *(const f32x4*)(q_ + 128 + cs * 4); Bq[(S) % 3] = *(const f32x4*)(q_ + 192 + cs * 4); }
    SCAN_LD(0); SCAN_LD(1);
#pragma unroll
    for (int s = 0; s < TC; s++) {
      if (s + 2 < TC) SCAN_LD(s + 2);
      f32x4 A = Aq[s % 3], Rr = Rq[s % 3], K = Kq[s % 3], Bv = Bq[s % 3];
      float v = v4[s >> 2][s & 3];
      f32x2 vv = (f32x2){v, v};
      f32x2 pp2 = __builtin_elementwise_fma(Xb, A.zw, Xa * A.xy);
      f32x2 Ua = __builtin_elementwise_fma(vv, K.xy, Xa);
      f32x2 Ub = __builtin_elementwise_fma(vv, K.zw, Xb);
      float pp = red16(pp2.x + pp2.y);
      f32x2 nu = (f32x2){-pp, -pp};
      Xa = __builtin_elementwise_fma(nu, Bv.xy, Ua);
      Xb = __builtin_elementwise_fma(nu, Bv.zw, Ub);
      f32x2 yy2 = __builtin_elementwise_fma(Xb, Rr.zw, Xa * Rr.xy);
      yp[s] = yy2.x + yy2.y;
    }
#undef SCAN_LD
    float ykeep;
    {
      const bool b3 = (cs & 8) != 0, b2 = (cs & 4) != 0, b1 = (cs & 2) != 0, b0 = (cs & 1) != 0;
      float a8[8], a4[4], a2[2];
#pragma unroll
      for (int s = 0; s < 8; s++) { float lo = yp[s], hi = yp[s + 8]; a8[s] = (b3 ? hi : lo) + dpp_get<0x140>(b3 ? lo : hi); }
#pragma unroll
      for (int s = 0; s < 4; s++) { float lo = a8[s], hi = a8[s + 4]; a4[s] = (b2 ? hi : lo) + dpp_get<0x141>(b2 ? lo : hi); }
#pragma unroll
      for (int s = 0; s < 2; s++) { float lo = a4[s], hi = a4[s + 2]; a2[s] = (b1 ? hi : lo) + dpp_get<0x4E>(b1 ? lo : hi); }
      { float lo = a2[0], hi = a2[1]; ykeep = (b0 ? hi : lo) + dpp_get<0xB1>(b0 ? lo : hi); }
    }
    Xa = Xa * g16.xy; Xb = Xb * g16.zw;
    yS[cs * 16 + rl] = ykeep;
    __syncthreads();
    {
      int step = ck * TC + ss; int i = iS + (e ? (T - 1 - step) : step);
      ydst[(size_t)i * 256 + h * 64 + rg * 16 + jj] = f2bf(yS[ss * 16 + jj]);
    }
  }
  __builtin_amdgcn_s_setprio(0);
#undef SCAN_PREFETCH
#undef UNPK
#undef UNPK2
}

#define LOG2E 1.4426950408889634f
#define LN2 0.6931471805599453f

template <bool IS_C>
__device__ __forceinline__ void attn_unit(const Params& p, int layer, int g0, int n, int unit, char* smem, int tid) {
  constexpr int NK = IS_C ? 288 : 192;
  constexpr int NT = IS_C ? 18 : 10;
  constexpr int VS = IS_C ? 304 : 208;
  constexpr int R = IS_C ? 128 : 64;
  bf16_t* Ks = (bf16_t*)smem;
  bf16_t* Vt = Ks + NK * 64;
  const int wave = tid >> 6, lane = tid & 63, fr = lane & 15, fq = lane >> 4;
  int dil, ibase, klo, khi, kcol, vcol, qcol, iq, wst, doff, br = 0, h = 0, hq = 0;
  if (IS_C) {
    int hk = unit & 1, ct = unit >> 1;
    int i0 = ct * 16, g = g0 + i0, s0, T; seqinfo(g, s0, T); int t0 = g - s0;
    dil = 1; ibase = i0 - 128;
    klo = max(0, 128 - t0); khi = min(NK, T - t0 + 128);
    kcol = 1792 + hk * 64; vcol = 1920 + hk * 64;
    hq = hk * 4 + wave; qcol = 1280 + hq * 64; iq = i0 + fr;
    wst = 0; doff = 128;
  } else {
    const int per = n >> 6;
    int bh = unit / per, u = unit - bh * per;
    br = bh >> 2; h = bh & 3;
    dil = br == 0 ? 1 : (br == 1 ? 4 : 16);
    int bidx = u / dil, res = u - bidx * dil;
    int S0 = bidx * 64 * dil, g = g0 + S0, s0, T; seqinfo(g, s0, T); int tS = g - s0;
    int qi0 = tS / dil, L = T / dil;
    ibase = S0 + res - 64 * dil;
    klo = max(0, 64 - qi0); khi = min(NK, L - qi0 + 64);
    kcol = 512 + h * 64; vcol = 768 + h * 64; qcol = 256 + h * 64;
    iq = S0 + res + (wave * 16 + fr) * dil;
    wst = (wave >> 1) * 32; doff = 64 + wave * 16;
  }
#pragma unroll 3
  for (int ch = tid; ch < NK * 8; ch += 256) {
    int key = ch >> 3, c8 = ch & 7;
    bool ok = key >= klo && key < khi;
    u32x4 kv = (u32x4){0u, 0u, 0u, 0u}, vv = (u32x4){0u, 0u, 0u, 0u};
    if (ok) {
      const bf16_t* rowp = p.proj2 + (size_t)(ibase + key * dil) * 2560;
      kv = *(const u32x4*)(rowp + kcol + c8 * 8);
      vv = *(const u32x4*)(rowp + vcol + c8 * 8);
    }
    *(u32x4*)(Ks + key * 64 + ((c8 ^ (key & 7)) * 8)) = kv;
    int pos = (key & ~31) | (((key >> 2) & 3) << 3) | (((key >> 4) & 1) << 2) | (key & 3);
    bf16_t* vd = Vt + (c8 * 8) * VS + pos;
    vd[0 * VS] = (bf16_t)(vv.x & 0xffffu); vd[1 * VS] = (bf16_t)(vv.x >> 16);
    vd[2 * VS] = (bf16_t)(vv.y & 0xffffu); vd[3 * VS] = (bf16_t)(vv.y >> 16);
    vd[4 * VS] = (bf16_t)(vv.z & 0xffffu); vd[5 * VS] = (bf16_t)(vv.z >> 16);
    vd[6 * VS] = (bf16_t)(vv.w & 0xffffu); vd[7 * VS] = (bf16_t)(vv.w >> 16);
  }
  const bf16_t* qrow = p.proj2 + (size_t)iq * 2560 + qcol;
  bf16x8 bq0 = *(const bf16x8*)(qrow + fq * 8);
  bf16x8 bq1 = *(const bf16x8*)(qrow + 32 + fq * 8);
  __syncthreads();
  f32x4 s[NT];
#pragma unroll
  for (int mt = 0; mt < NT; mt++) {
    int key = wst + mt * 16 + fr;
    const bf16_t* kr = Ks + key * 64;
    bf16x8 a0 = *(const bf16x8*)(kr + ((fq ^ (key & 7)) * 8));
    bf16x8 a1 = *(const bf16x8*)(kr + (((4 + fq) ^ (key & 7)) * 8));
    f32x4 acc = (f32x4){0.f, 0.f, 0.f, 0.f};
    acc = __builtin_amdgcn_mfma_f32_16x16x32_bf16(a0, bq0, acc, 0, 0, 0);
    acc = __builtin_amdgcn_mfma_f32_16x16x32_bf16(a1, bq1, acc, 0, 0, 0);
    s[mt] = acc;
  }
  const int lo_c = max(klo, doff + fr - R), hi_c = min(khi - 1, doff + fr + R);
  float mx = -1e30f;
#pragma unroll
  for (int mt = 0; mt < NT; mt++)
#pragma unroll
    for (int j = 0; j < 4; j++) {
      int kap = wst + mt * 16 + fq * 4 + j;
      bool v = kap >= lo_c && kap <= hi_c;
      float sv = v ? s[mt][j] : -1e30f;
      s[mt][j] = sv;
      mx = fmaxf(mx, sv);
    }
  mx = fmaxf(mx, __shfl_xor(mx, 16));
  mx = fmaxf(mx, __shfl_xor(mx, 32));
  float sink2 = 0.f;
  if (IS_C) { sink2 = p.sink[layer * 8 + hq] * LOG2E; mx = fmaxf(mx, sink2); }
  float sum = 0.f;
  unsigned pk[NT / 2][4];
#pragma unroll
  for (int mt = 0; mt < NT; mt++) {
    float p0 = exp2f(s[mt][0] - mx), p1 = exp2f(s[mt][1] - mx), p2 = exp2f(s[mt][2] - mx), p3 = exp2f(s[mt][3] - mx);
    sum += (p0 + p1) + (p2 + p3);
    pk[mt >> 1][(mt & 1) * 2 + 0] = cvt_pk_bf16(p0, p1);
    pk[mt >> 1][(mt & 1) * 2 + 1] = cvt_pk_bf16(p2, p3);
  }
  sum += __shfl_xor(sum, 16);
  sum += __shfl_xor(sum, 32);
  if (IS_C) sum += exp2f(sink2 - mx);
  f32x4 o[4];
#pragma unroll
  for (int dt = 0; dt < 4; dt++) o[dt] = (f32x4){0.f, 0.f, 0.f, 0.f};
#pragma unroll
  for (int u = 0; u < NT / 2; u++) {
    u32x4 pb = (u32x4){pk[u][0], pk[u][1], pk[u][2], pk[u][3]};
    bf16x8 bfrag = __builtin_bit_cast(bf16x8, pb);
#pragma unroll
    for (int dt = 0; dt < 4; dt++) {
      bf16x8 a = *(const bf16x8*)(Vt + (dt * 16 + fr) * VS + wst + u * 32 + fq * 8);
      o[dt] = __builtin_amdgcn_mfma_f32_16x16x32_bf16(a, bfrag, o[dt], 0, 0, 0);
    }
  }
  const float inv = 1.f / sum;
  if (IS_C) {
    const bf16_t* grow = p.proj2 + (size_t)iq * 2560 + 2048 + hq * 64;
    bf16_t* orow = p.Tb + (size_t)iq * 1024 + 512 + hq * 64;
#pragma unroll
    for (int dt = 0; dt < 4; dt++) {
      uint2 gg = *(const uint2*)(grow + dt * 16 + fq * 4);
      float g0f = __uint_as_float(gg.x << 16), g1f = __uint_as_float(gg.x & 0xffff0000u);
      float g2f = __uint_as_float(gg.y << 16), g3f = __uint_as_float(gg.y & 0xffff0000u);
      uint2 ov;
      ov.x = cvt_pk_bf16(o[dt][0] * inv * silu(g0f), o[dt][1] * inv * silu(g1f));
      ov.y = cvt_pk_bf16(o[dt][2] * inv * silu(g2f), o[dt][3] * inv * silu(g3f));
      *(uint2*)(orow + dt * 16 + fq * 4) = ov;
    }
  } else {
    bf16_t* orow = p.obuf + ((size_t)br * n + iq) * 256 + h * 64;
#pragma unroll
    for (int dt = 0; dt < 4; dt++) {
      uint2 ov;
      ov.x = cvt_pk_bf16(o[dt][0] * inv, o[dt][1] * inv);
      ov.y = cvt_pk_bf16(o[dt][2] * inv, o[dt][3] * inv);
      *(uint2*)(orow + dt * 16 + fq * 4) = ov;
    }
    if (fq == 0) p.lse[((size_t)br * n + iq) * 4 + h] = (mx + __log2f(sum)) * LN2;
  }
  __syncthreads();
}

__device__ __forceinline__ void attn_items(const Params& p, int layer, int g0, int n, int first_blk, int nblk, char* smem, int vb) {
  const int TIDX = opaque_tid();
  const int nC = 2 * (n >> 4), nB = 12 * (n >> 6);
  int it = vb - first_blk;
  for (; it < nC; it += nblk) attn_unit<true>(p, layer, g0, n, it, smem, TIDX);
  for (it -= nC; it < nB; it += nblk) attn_unit<false>(p, layer, g0, n, it, smem, TIDX);
}

__device__ __forceinline__ int mix_vb(int nscan_blk) {
  const int G = gridDim.x, half = G >> 1;
  const int b = blockIdx.x;
  if ((G & 1) == 0 && nscan_blk <= half) {
    if (b < nscan_blk) return b;
    return b;
  }
  return b;
}
__device__ __forceinline__ void mix_counts(int g0, int n, int& nP, int& nS, int& gP0, int& gS0) {
  gP0 = g0; int gP1 = min(g0 + n, 32768); nP = gP1 > gP0 ? (gP1 - gP0) / 8192 : 0;
  gS0 = max(g0, 32768); int gS1 = g0 + n; nS = gS1 > gS0 ? (gS1 - gS0) / 16384 : 0;
}
__device__ __forceinline__ void phase_mix(const Params& p, int layer, int g0, int n, char* smem, int iso_lo, int iso_n) {
  int nP, nS, gP0, gS0; mix_counts(g0, n, nP, nS, gP0, gS0);
  const int nitems = (nP + nS) * 32;
  const int nscan_blk = min(nitems, (int)gridDim.x / 2);
  const int vb = mix_vb(nscan_blk);
  if (vb < nscan_blk) {
    for (int it = vb; it < nitems; it += nscan_blk) {
      int sq, rem, iS, T;
      if (it < nS * 32) { sq = it / 32; rem = it % 32; iS = (gS0 - g0) + sq * 16384; T = 16384; }
      else { int j = it - nS * 32; sq = j / 32; rem = j % 32; iS = (gP0 - g0) + sq * 8192; T = 8192; }
      int h = rem >> 3, e = (rem >> 2) & 1, rg = rem & 3;
      __syncthreads();
      scan_item(p, n, iS, T, h, e, rg, smem);
    }
  } else {
    const int b = blockIdx.x;
    if (iso_n > 0) {
      if (b >= iso_lo && b < iso_lo + iso_n) return;
      const int r = (b < iso_lo) ? (b - nscan_blk) : (b - nscan_blk - iso_n);
      attn_items(p, layer, g0, n, 0, gridDim.x - nscan_blk - iso_n, smem, r);
    } else attn_items(p, layer, g0, n, nscan_blk, gridDim.x - nscan_blk, smem, vb);
  }
}

__device__ __forceinline__ float bflo(unsigned w) { return __uint_as_float(w << 16); }
__device__ __forceinline__ float bfhi(unsigned w) { return __uint_as_float(w & 0xffff0000u); }
__device__ __forceinline__ void phase_fina(const Params& p, int layer, int g0, int n, const Rg& rg) {
  const int TIDX = opaque_tid();
  const int h2 = TIDX & 127, c2 = h2 * 2, tsel = TIDX >> 7, head = h2 >> 5;
  const float2 lw = *(const float2*)(p.ln_w + layer * 256 + c2), lb = *(const float2*)(p.ln_b + layer * 256 + c2);
  const bf16_t* Pv = p.PX;
  const int UN = 4;
  for (int i0 = rg.lo + rg.br * (2 * UN); i0 < rg.hi; i0 += rg.nb * (2 * UN)) {
    unsigned yf[UN], yb[UN], pv[UN], ga[UN], gbv[UN], o0[UN], o1[UN], o2[UN];
    float bonv[UN], l0[UN], l1[UN], l2[UN];
#pragma unroll
    for (int u = 0; u < UN; u++) {
      const size_t i = i0 + u * 2 + tsel;
      yf[u] = *(const unsigned*)(p.yf + i * 256 + c2); yb[u] = *(const unsigned*)(p.yb + i * 256 + c2);
      pv[u] = *(const unsigned*)(Pv + i * 256 + c2); bonv[u] = p.bonus[i * 4 + head];
      ga[u] = *(const unsigned*)(p.proj2 + i * 2560 + c2); gbv[u] = *(const unsigned*)(p.proj2 + i * 2560 + 1024 + c2);
      l0[u] = p.lse[((size_t)0 * n + i) * 4 + head]; l1[u] = p.lse[((size_t)1 * n + i) * 4 + head]; l2[u] = p.lse[((size_t)2 * n + i) * 4 + head];
      o0[u] = *(const unsigned*)(p.obuf + ((size_t)0 * n + i) * 256 + c2); o1[u] = *(const unsigned*)(p.obuf + ((size_t)1 * n + i) * 256 + c2);
      o2[u] = *(const unsigned*)(p.obuf + ((size_t)2 * n + i) * 256 + c2);
    }
#pragma unroll
    for (int u = 0; u < UN; u++) {
      const size_t i = i0 + u * 2 + tsel;
      const float y0 = bflo(yf[u]) + bflo(yb[u]), y1 = bfhi(yf[u]) + bfhi(yb[u]);
      float s = xrow16_sum(red16(y0 + y1));
      const float mean = s * (1.f / 64.f);
      const float d0 = y0 - mean, d1 = y1 - mean;
      float q = xrow16_sum(red16(d0 * d0 + d1 * d1));
      const float rs = rsqrtf(q * (1.f / 64.f) + 64e-5f);
      const float a0 = (d0 * rs * lw.x + lb.x + bonv[u] * bflo(pv[u])) * silu(bflo(ga[u]));
      const float a1 = (d1 * rs * lw.y + lb.y + bonv[u] * bfhi(pv[u])) * silu(bfhi(ga[u]));
      *(unsigned*)(p.Tb + i * 1024 + c2) = cvt_pk_bf16(a0, a1);
      const float lm = fmaxf(l0[u], fmaxf(l1[u], l2[u]));
      const float e0 = __expf(l0[u] - lm), e1 = __expf(l1[u] - lm), e2 = __expf(l2[u] - lm);
      const float inv = 1.f / (e0 + e1 + e2);
      const float b0 = (e0 * bflo(o0[u]) + e1 * bflo(o1[u]) + e2 * bflo(o2[u])) * inv * silu(bflo(gbv[u]));
      const float b1 = (e0 * bfhi(o0[u]) + e1 * bfhi(o1[u]) + e2 * bfhi(o2[u])) * inv * silu(bfhi(gbv[u]));
      *(unsigned*)(p.Tb + i * 1024 + 256 + c2) = cvt_pk_bf16(b0, b1);
    }
  }
}

__device__ __forceinline__ void phase_fnorm(const Params& p, int g0, const Rg& rg) {
  const int TIDX = opaque_tid();
  int wave = TIDX >> 6, lane = TIDX & 63;
  const float4* gam = (const float4*)p.final_g;
  for (int i = rg.lo + rg.br * 4 + wave; i < rg.hi; i += rg.nb * 4) {
    float4* xr = (float4*)(p.out + (size_t)(g0 + i) * DM);
    float4 v[4]; float ss = 0.f;
#pragma unroll
    for (int q = 0; q < 4; q++) { v[q] = xr[q * 64 + lane]; ss += v[q].x * v[q].x + v[q].y * v[q].y + v[q].z * v[q].z + v[q].w * v[q].w; }
    ss = wave_sum(ss);
    float rstd = rsqrtf(ss * (1.f / 1024.f) + 1e-5f);
#pragma unroll
    for (int q = 0; q < 4; q++) {
      float4 gg = gam[q * 64 + lane];
      float4 o; o.x = v[q].x * rstd * gg.x; o.y = v[q].y * rstd * gg.y; o.z = v[q].z * rstd * gg.z; o.w = v[q].w * rstd * gg.w;
      xr[q * 64 + lane] = o;
    }
  }
}

__global__ void __launch_bounds__(256, 2) mega(Params p, int ph_lo, int ph_hi) {
  __shared__ __attribute__((aligned(16))) char smem[SMEM_BYTES];
  __shared__ uint4 xb_words;
  __shared__ uint4 xb_words2;
  if (threadIdx.x == 0) { xb_words = make_uint4(0u, 0u, 0u, 0u); xb_words2 = make_uint4(0u, 0u, 0u, 0u); }
  __syncthreads();
  const int n = p.ntok_pass;
  int nP, nS, gP0, gS0; mix_counts(0, n, nP, nS, gP0, gS0);
  const int nitems = (nP + nS) * 32;
  const int nscan_blk = min(nitems, (int)gridDim.x / 2);
  const int nsamp = nS * 32;
  const bool overlap = (p.npass == 1) && (nscan_blk == nitems) && nS > 0 && nP > 0 && ((gridDim.x & 7) == 0) && ((nsamp & 7) == 0) && (nsamp <= (nscan_blk >> 1));
  const int vb = mix_vb(nscan_blk);
  const bool sscan = overlap && (vb < nsamp);
  const int snb = (int)gridDim.x - nsamp, srank = vb - nsamp, half_g = (int)gridDim.x >> 1;
  XcdBarrier xb = xcd_barrier_post(p.bar, (volatile LAS unsigned*)&xb_words, gridDim.x, true);
  XcdBarrier xs = xcd_barrier_post(p.bar + 4096, (volatile LAS unsigned*)&xb_words2, (unsigned)snb, overlap && !sscan);
  const int NSTEP = overlap ? 22 : (ph_hi - ph_lo);
  int st0 = 0;
  if (overlap || ph_lo == 0) {
    phase_wconv(p, smem);
    if (overlap) {
      Rg rg; rg.lo = 0; rg.hi = n; rg.br = blockIdx.x; rg.nb = gridDim.x; rg.xb = p.PX; rg.xbase = 0; rg.xr = blockIdx.x >> 3; rg.xn = gridDim.x >> 3;
      phase_xnorm(p, 0, 0, rg);
    }
    if (overlap || 1 < ph_hi) xcd_barrier(xb);
    st0 = overlap ? 2 : 1;
  }
  for (int st = st0; st < NSTEP; st++) {
    int op, layer, rsel, who, bar, g0 = 0, colset = 0;
    if (overlap) {
      switch (st) {
        case 1:  op = 1; layer = 0; rsel = 0; who = 0; bar = 1; break;
        case 2:  op = 2; layer = 0; rsel = 0; who = 0; bar = 1; break;
        case 3:  op = 3; layer = 0; rsel = 0; who = 0; bar = 1; break;
        case 4:  op = 4; layer = 0; rsel = 0; who = 0; bar = 2; break;
        case 5:  op = 5; layer = 0; rsel = 1; who = 1; bar = 2; break;
        case 6:  op = 6; layer = 0; rsel = 1; who = 1; bar = 2; break;
        case 7:  op = 1; layer = 1; rsel = 1; who = 1; bar = 2; break;
        case 8:  op = 2; layer = 1; rsel = 1; who = 1; bar = 1; colset = 1; break;
        case 9:  op = 5; layer = 0; rsel = 2; who = 0; bar = 1; break;
        case 10: op = 6; layer = 0; rsel = 2; who = 0; bar = 1; break;
        case 11: op = 1; layer = 1; rsel = 2; who = 0; bar = 1; break;
        case 12: op = 2; layer = 1; rsel = 2; who = 0; bar = 1; break;
        case 13: op = 3; layer = 1; rsel = 0; who = 0; bar = 1; break;
        case 14: op = 4; layer = 1; rsel = 0; who = 0; bar = 2; break;
        case 15: op = 2; layer = 1; rsel = 1; who = 1; bar = 2; colset = 2; break;
        case 16: op = 5; layer = 1; rsel = 1; who = 1; bar = 2; break;
        case 17: op = 6; layer = 1; rsel = 1; who = 1; bar = 2; break;
        case 18: op = 7; layer = 1; rsel = 1; who = 1; bar = 1; break;
        case 19: op = 5; layer = 1; rsel = 2; who = 0; bar = 1; break;
        case 20: op = 6; layer = 1; rsel = 2; who = 0; bar = 1; break;
        default: op = 7; layer = 1; rsel = 2; who = 0; bar = 0; break;
      }
    } else {
      const int ph = ph_lo + st;
      rsel = 0; who = 0; bar = (ph + 1 < ph_hi) ? 1 : 0; layer = 0;
      if (ph == 0) op = 0;
      else {
        int q = ph - 1, pass = q / 13, r = q % 13;
        g0 = pass * n;
        if (r == 12) op = 7;
        else { layer = r / 6; int s = r % 6; op = (s == 0) ? 1 : (s == 1) ? 2 : (s == 2) ? 3 : (s == 3) ? 4 : (s == 4) ? 5 : 6; }
      }
    }
    const bool iso = overlap && (st >= 14) && (st <= 18);
    const bool partner = ((int)blockIdx.x >= half_g) && ((int)blockIdx.x < half_g + nsamp);
    if (!(who == 1 && sscan) && !(iso && partner && who == 1)) {
      Rg rg;
      if (rsel == 0) { rg.lo = 0; rg.hi = n; rg.br = blockIdx.x; rg.nb = gridDim.x; rg.xb = p.PX; rg.xbase = 0; rg.xr = blockIdx.x >> 3; rg.xn = gridDim.x >> 3; }
      else if (rsel == 1) {
        rg.lo = 0; rg.hi = 32768; rg.xb = p.xb2; rg.xbase = 0;
        if (iso) {
          const int bb = (int)blockIdx.x - nsamp - (((int)blockIdx.x >= half_g + nsamp) ? nsamp : 0);
          rg.br = bb; rg.nb = snb - nsamp; rg.xr = bb >> 3; rg.xn = (snb - nsamp) >> 3;
        } else { rg.br = srank; rg.nb = snb; rg.xr = ((int)blockIdx.x - nsamp) >> 3; rg.xn = snb >> 3; }
      }
      else { rg.lo = 32768; rg.hi = n; rg.br = blockIdx.x; rg.nb = gridDim.x; rg.xb = p.obuf; rg.xbase = 32768; rg.xr = blockIdx.x >> 3; rg.xn = gridDim.x >> 3; }
      switch (op) {
        case 1: phase_xnorm(p, layer, g0, rg); break;
        case 2: phase_gemm<0>(p, layer, g0, rg, smem, colset); break;
        case 3: phase_prep(p, layer, g0, n, rg, smem); break;
        case 4: phase_mix(p, layer, g0, n, smem, half_g, iso ? nsamp : 0); break;
        case 5: phase_fina(p, layer, g0, n, rg); break;
        case 6: phase_gemm<1>(p, layer, g0, rg, smem, 0); break;
        default: phase_fnorm(p, g0, rg); break;
      }
    }
    if (bar == 1) { if (ph_hi < 0) cg::this_grid().sync(); else xcd_barrier(xb); }
    else if (bar == 2 && !sscan) xcd_barrier(xs);
  }
}

__global__ void noop_kernel(int* x) { if (x == nullptr && threadIdx.x == 12345) *x = 0; }

extern "C" void kernel_launch(void* const* d_in, const int* in_sizes, int n_in, void* d_out, int out_size, void* d_ws,
                              size_t ws_size, hipStream_t stream) {
  static int grid_blocks = 0;
  if (!grid_blocks) {
    int dev = 0, cus = 0, per_cu = 0;
    hipGetDevice(&dev);
    hipDeviceGetAttribute(&cus, hipDeviceAttributeMultiprocessorCount, dev);
    hipOccupancyMaxActiveBlocksPerMultiprocessor(&per_cu, mega, 256, 0);
    if (per_cu > 2) per_cu = 2;
    if (per_cu < 1) per_cu = 1;
    grid_blocks = (cus * per_cu) & ~7;
  }
  Params p;
  memset((void*)&p, 0, sizeof(p));
  p.xin0 = (const float*)d_in[0]; p.xin1 = (const float*)d_in[1];
  p.norm_g = (const float*)d_in[2]; p.w_in = (const float*)d_in[3]; p.mu = (const float*)d_in[4];
  p.w0 = (const float*)d_in[5]; p.w2 = (const float*)d_in[6]; p.a0 = (const float*)d_in[7]; p.a2 = (const float*)d_in[8];
  p.k_k = (const float*)d_in[9]; p.k_a = (const float*)d_in[10]; p.r_k = (const float*)d_in[11];
  p.ln_w = (const float*)d_in[12]; p.ln_b = (const float*)d_in[13]; p.sink = (const float*)d_in[14];
  p.w_out = (const float*)d_in[15]; p.final_g = (const float*)d_in[16];
  p.out = (float*)d_out;
  auto need = [](size_t n) -> size_t {
    return 32768 + (size_t)2 * 3584 * 1024 * 2 + (size_t)2 * 1024 * 1024 * 2 + n * (2048 + 5120 + 4608 + 2048 + 16 + 1536 + 48) + 8192 + (size_t)16384 * 32 * 8 + 256 + n * 128 + 256 + 2 * 64 * 256 * 8 + 256 + 2 * 4 * 256 * 64 * 2 + 256;
  };
  int npass = (ws_size >= need(NTOK)) ? 1 : 2;
  size_t n = NTOK / npass;
  char* w = (char*)d_ws; size_t off = 0;
  auto take = [&](size_t bytes) { char* r = w + off; off += (bytes + 255) & ~(size_t)255; return r; };
  p.bar = (unsigned*)take(32768);
  p.WinT = (bf16_t*)take((size_t)2 * 3584 * 1024 * 2);
  p.WoutT = (bf16_t*)take((size_t)2 * 1024 * 1024 * 2);
  p.Tb = (bf16_t*)take(n * 2048);
  p.proj2 = (bf16_t*)take(n * 5120);
  p.PX = (bf16_t*)take(n * 4608);
  p.yf = (bf16_t*)take(n * 512);
  p.yb = (bf16_t*)take(n * 512);
  p.xb2 = (bf16_t*)take(n * 1024);
  p.bonus = (float*)take(n * 16);
  p.obuf = (bf16_t*)take(n * 1536);
  p.lse = (float*)take(n * 48);
  p.ropetab = (float2*)take((size_t)16384 * 32 * 8);
  p.g16 = (float*)take(n / 16 * 512 * 4);
  p.lw = (uint2*)take((size_t)2 * 64 * 256 * 8);
  p.lwT = (bf16_t*)take((size_t)2 * 4 * 256 * 64 * 2);
  p.npass = npass; p.ntok_pass = (int)n;
  const int nph = 1 + 13 * npass;
  hipMemsetAsync(p.bar, 0, 32768, stream);
  int ph_lo = 0, ph_hi = nph;
  void* args[] = {(void*)&p, (void*)&ph_lo, (void*)&ph_hi};
  hipError_t e = hipLaunchCooperativeKernel((const void*)mega, dim3(grid_blocks), dim3(256), args, 0, stream);
  if (e != hipSuccess) fprintf(stderr, "cooperative launch failed: %s (grid %d)\n", hipGetErrorString(e), grid_blocks);
}
```

```cpp
#include <hip/hip_runtime.h>
#include <hip/hip_cooperative_groups.h>
#include <stdint.h>
#include <stdio.h>
#include <string.h>
namespace cg = cooperative_groups;

typedef unsigned short bf16_t;
using bf16x8 = __attribute__((ext_vector_type(8))) short;
using f32x4 = __attribute__((ext_vector_type(4))) float;
using u32x4 = __attribute__((ext_vector_type(4))) unsigned int;
using f32x2 = __attribute__((ext_vector_type(2))) float;

#define NTOK 65536
#ifndef DUP
#define DUP -1
#endif
#define DM 1024
#define SMEM_BYTES 75776

__device__ __forceinline__ float bf2f(bf16_t h) { return __uint_as_float(((unsigned)h) << 16); }
__device__ __forceinline__ unsigned cvt_pk_bf16(float lo, float hi) {
  unsigned r; asm("v_cvt_pk_bf16_f32 %0,%1,%2" : "=v"(r) : "v"(lo), "v"(hi)); return r;
}
__device__ __forceinline__ bf16_t f2bf(float f) { return (bf16_t)cvt_pk_bf16(f, f); }
__device__ __forceinline__ unsigned pack2(float a, float b) { return cvt_pk_bf16(a, b); }
__device__ __forceinline__ float wave_sum(float v) {
#pragma unroll
  for (int o = 32; o > 0; o >>= 1) v += __shfl_xor(v, o);
  return v;
}
__device__ __forceinline__ float wave_max(float v) {
#pragma unroll
  for (int o = 32; o > 0; o >>= 1) v = fmaxf(v, __shfl_xor(v, o));
  return v;
}
template <int CTRL>
__device__ __forceinline__ float dpp_add(float x) {
  int y = __builtin_amdgcn_update_dpp(0, __float_as_int(x), CTRL, 0xf, 0xf, true);
  return x + __int_as_float(y);
}
template <int CTRL>
__device__ __forceinline__ float dpp_get(float x) {
  return __int_as_float(__builtin_amdgcn_update_dpp(0, __float_as_int(x), CTRL, 0xf, 0xf, true));
}
__device__ __forceinline__ float red16(float x) {
  x = dpp_add<0xB1>(x);
  x = dpp_add<0x4E>(x);
  x = dpp_add<0x141>(x);
  x = dpp_add<0x140>(x);
  return x;
}
__device__ __forceinline__ float xrow16_sum(float v) {
  unsigned x = __float_as_uint(v);
  auto r = __builtin_amdgcn_permlane16_swap(x, x, false, false);
  return __uint_as_float(r[0]) + __uint_as_float(r[1]);
}
__device__ __forceinline__ float xrow32_sum(float v) {
  unsigned x = __float_as_uint(v);
  auto r = __builtin_amdgcn_permlane32_swap(x, x, false, false);
  return __uint_as_float(r[0]) + __uint_as_float(r[1]);
}
__device__ __forceinline__ float wave_sum_fast(float v) {
  v = red16(v);
  v = xrow16_sum(v);
  v = xrow32_sum(v);
  return v;
}
__device__ __forceinline__ int opaque_tid() { int t = threadIdx.x; asm volatile("" : "+v"(t)); return t; }
__device__ __forceinline__ float silu(float g) { return g / (1.f + __expf(-g)); }

#define XB_TMO      128
#define XB_XCNT(j)  (256  + 64 * (j))
#define XB_XSUB(j)  (1280 + 64 * (j))
#define XB_XGEN(j)  (2304 + 64 * (j))
#define XB_TOP      3328
#define XB_TOPGEN   3392
#define XCD_BAR_WORDS 3456
#define XB_SPIN_CAP (1u << 18)
#define LAS __attribute__((address_space(3)))

__device__ __forceinline__ unsigned xb_ld(unsigned* p)              { return __hip_atomic_load(p, __ATOMIC_RELAXED, __HIP_MEMORY_SCOPE_AGENT); }
__device__ __forceinline__ unsigned xb_add(unsigned* p, unsigned v) { return __hip_atomic_fetch_add(p, v, __ATOMIC_RELAXED, __HIP_MEMORY_SCOPE_AGENT); }
__device__ __forceinline__ unsigned xb_xcc_id() { return (unsigned)__builtin_amdgcn_s_getreg((3 << 11) | 20) & 0xFu; }
#define XB_SPIN(cond, bar) do { unsigned _sp = 0; while (cond) { __builtin_amdgcn_s_sleep(4); \
    if ((++_sp & 255u) == 0u) { if (xb_ld(&(bar)[XB_TMO])) break; if (_sp > XB_SPIN_CAP) { atomicAdd(&(bar)[XB_TMO], 1u); break; } } } } while (0)

struct XcdBarrier {
    unsigned total;
    unsigned* bar; unsigned x;
    volatile LAS unsigned* st;
};

__device__ __forceinline__ XcdBarrier xcd_barrier_post(unsigned* bar, volatile LAS unsigned* st, unsigned total, bool member) {
    XcdBarrier b; b.total = total; b.bar = bar; b.x = xb_xcc_id(); b.st = st;
    if (threadIdx.x == 0 && member) (void)xb_add(&bar[XB_XCNT(b.x)], 1u);
    return b;
}
__device__ __forceinline__ void xcd_barrier_complete(unsigned* bar, unsigned x, unsigned& nloc, unsigned& nx, unsigned G) {
    unsigned sum, cnt, mine, sp = 0u;
    for (;;) {
        sum = 0u; cnt = 0u; mine = 0u;
#pragma unroll
        for (unsigned j = 0; j < 16; ++j) { const unsigned c = xb_ld(&bar[XB_XCNT(j)]); sum += c; cnt += (c > 0u) ? 1u : 0u; mine = (j == x) ? c : mine; }
        if (sum == G) break;
        __builtin_amdgcn_s_sleep(1);
        if ((++sp & 255u) == 0u) { if (xb_ld(&bar[XB_TMO])) break; if (sp > XB_SPIN_CAP) { atomicAdd(&bar[XB_TMO], 1u); break; } }
    }
    nloc = mine > 0u ? mine : 1u; nx = cnt > 0u ? cnt : 1u;
}

__device__ __forceinline__ void xcd_barrier(const XcdBarrier& b) {
    asm volatile("s_waitcnt vmcnt(0)" ::: "memory");
    __syncthreads();
    if (threadIdx.x == 0) {
        unsigned* bar = b.bar;
        __builtin_amdgcn_s_waitcnt(0);
        unsigned nloc = b.st[0], nx = b.st[1];
        if (nloc == 0u) { xcd_barrier_complete(bar, b.x, nloc, nx, b.total); b.st[0] = nloc; b.st[1] = nx; }
        const unsigned old = xb_add(&bar[XB_XSUB(b.x)], 1u);
        const unsigned gen = old / nloc;
        if (old + 1u == (gen + 1u) * nloc) {
            __builtin_amdgcn_fence(__ATOMIC_RELEASE, "agent");
            asm volatile("s_waitcnt vmcnt(0)" ::: "memory");
            const unsigned og = xb_add(&bar[XB_TOP], 1u);
            const unsigned tg = og / nx;
            if (og + 1u == (tg + 1u) * nx) xb_add(&bar[XB_TOPGEN], 1u);
            else XB_SPIN(xb_ld(&bar[XB_TOPGEN]) == tg, bar);
            __builtin_amdgcn_fence(__ATOMIC_ACQUIRE, "agent");
            xb_add(&bar[XB_XGEN(b.x)], 1u);
            asm volatile("s_waitcnt vmcnt(0)" ::: "memory");
        } else {
            XB_SPIN(xb_ld(&bar[XB_XGEN(b.x)]) == gen, bar);
            __builtin_amdgcn_fence(__ATOMIC_ACQUIRE, "agent");
            asm volatile("s_waitcnt vmcnt(0)" ::: "memory");
        }
    }
    __syncthreads();
}


struct Params {
  const float* xin0; const float* xin1;
  const float* norm_g; const float* w_in; const float* mu; const float* w0; const float* w2; const float* a0;
  const float* a2; const float* k_k; const float* k_a; const float* r_k; const float* ln_w; const float* ln_b;
  const float* sink; const float* w_out; const float* final_g;
  float* out;
  bf16_t* WinT; bf16_t* WoutT;
  bf16_t* Tb; bf16_t* proj2; bf16_t* PX;
  bf16_t* yf; bf16_t* yb; float* bonus; bf16_t* xb2;
  bf16_t* obuf; float* lse; float2* ropetab; float* g16; uint2* lw; bf16_t* lwT;
  unsigned* bar;
  int npass; int ntok_pass;
};

struct Rg { int lo, hi, br, nb; bf16_t* xb; int xbase; int xr, xn; };
__device__ __forceinline__ void seqinfo(int g, int& s0, int& T) {
  if (g < 32768) { T = 8192; s0 = g & ~8191; } else { T = 16384; s0 = g & ~16383; }
}
__device__ __forceinline__ const float* xrow(const Params& p, int g) {
  return g < 32768 ? p.xin0 + (size_t)g * DM : p.xin1 + (size_t)(g - 32768) * DM;
}

__device__ __forceinline__ void phase_wconv(const Params& p, char* smem) {
  const int TIDX = opaque_tid();
  for (int idx = blockIdx.x * 256 + TIDX; idx < 2 * 64 * 256; idx += gridDim.x * 256) {
    int layer = idx >> 14, l = (idx >> 8) & 63, cc = idx & 255;
    size_t of = (size_t)((layer * 2 + 0) * 64 + l) * 256 + cc, ob = (size_t)((layer * 2 + 1) * 64 + l) * 256 + cc;
    uint2 o; o.x = pack2(p.w2[of], p.w2[ob]); o.y = pack2(p.a2[of], p.a2[ob]);
    p.lw[idx] = o;
  }
  for (int idx = blockIdx.x * 256 + TIDX; idx < 2 * 4 * 256 * 64; idx += gridDim.x * 256) {
    int l = idx & 63, cc = (idx >> 6) & 255, g = (idx >> 14) & 3, layer = idx >> 16;
    const float* srcw = (g < 2) ? p.w2 : p.a2;
    p.lwT[idx] = f2bf(srcw[(size_t)((layer * 2 + (g & 1)) * 64 + l) * 256 + cc]);
  }
  for (int idx = blockIdx.x * 256 + TIDX; idx < 16384 * 32; idx += gridDim.x * 256) {
    int t = idx >> 5, fi = idx & 31;
    double inv = exp2(-(double)fi * (13.287712379549449 / 32.0));
    double ang = (double)t * inv;
    double sn, cs; sincos(ang, &sn, &cs);
    p.ropetab[idx] = make_float2((float)cs, (float)sn);
  }
  float (*tile)[65] = (float (*)[65])smem;
  const int per_layer = 16 * 56 + 16 * 16;
  for (int it = blockIdx.x; it < 2 * per_layer; it += gridDim.x) {
    int l = it / per_layer, r = it % per_layer;
    const float* src; bf16_t* dst; int N, kt, nt;
    if (r < 896) { kt = r / 56; nt = r % 56; src = p.w_in + (size_t)l * 1024 * 3584; dst = p.WinT + (size_t)l * 3584 * 1024; N = 3584; }
    else { r -= 896; kt = r / 16; nt = r % 16; src = p.w_out + (size_t)l * 1024 * 1024; dst = p.WoutT + (size_t)l * 1024 * 1024; N = 1024; }
    for (int e = TIDX; e < 4096; e += 256) { int i = e >> 6, j = e & 63; tile[i][j] = src[(size_t)(kt * 64 + i) * N + nt * 64 + j]; }
    __syncthreads();
    for (int e = TIDX; e < 4096; e += 256) { int j = e >> 6, i = e & 63; dst[(size_t)(nt * 64 + j) * 1024 + kt * 64 + i] = f2bf(tile[i][j]); }
    __syncthreads();
  }
}

__device__ __forceinline__ void phase_xnorm(const Params& p, int layer, int g0, const Rg& rg) {
  const int TIDX = opaque_tid();
  int wave = TIDX >> 6, lane = TIDX & 63;
  const float4* gam = (const float4*)(p.norm_g + layer * 1024);
  const int stride = rg.nb * 4;
  for (int ia = rg.lo + rg.br * 4 + wave; ia < rg.hi; ia += 2 * stride) {
    const int ib = ia + stride; const bool hb = ib < rg.hi;
    const float4* xa = (const float4*)((layer == 0) ? xrow(p, g0 + ia) : (p.out + (size_t)(g0 + ia) * DM));
    const float4* xb = (const float4*)((layer == 0) ? xrow(p, g0 + (hb ? ib : ia)) : (p.out + (size_t)(g0 + (hb ? ib : ia)) * DM));
    float4 va[4], vb[4]; float sa = 0.f, sb = 0.f;
#pragma unroll
    for (int q = 0; q < 4; q++) { va[q] = xa[q * 64 + lane]; vb[q] = xb[q * 64 + lane]; }
#pragma unroll
    for (int q = 0; q < 4; q++) {
      sa += va[q].x * va[q].x + va[q].y * va[q].y + va[q].z * va[q].z + va[q].w * va[q].w;
      sb += vb[q].x * vb[q].x + vb[q].y * vb[q].y + vb[q].z * vb[q].z + vb[q].w * vb[q].w;
    }
    sa = wave_sum_fast(sa); sb = wave_sum_fast(sb);
    float ra = rsqrtf(sa * (1.f / 1024.f) + 1e-5f), rb = rsqrtf(sb * (1.f / 1024.f) + 1e-5f);
    uint2* da = (uint2*)(rg.xb + (size_t)(ia - rg.xbase) * 1024);
    uint2* db = (uint2*)(rg.xb + (size_t)(ib - rg.xbase) * 1024);
#pragma unroll
    for (int q = 0; q < 4; q++) {
      float4 gg = gam[q * 64 + lane];
      uint2 o; o.x = pack2(va[q].x * ra * gg.x, va[q].y * ra * gg.y); o.y = pack2(va[q].z * ra * gg.z, va[q].w * ra * gg.w);
      da[q * 64 + lane] = o;
      if (hb) { uint2 o2; o2.x = pack2(vb[q].x * rb * gg.x, vb[q].y * rb * gg.y); o2.y = pack2(vb[q].z * rb * gg.z, vb[q].w * rb * gg.w); db[q * 64 + lane] = o2; }
    }
  }
}

template <int MODE>
__device__ __forceinline__ void phase_gemm(const Params& p, int layer, int g0, const Rg& rg, char* smem, int colset) {
  const int TIDX = opaque_tid();
  const int tid = TIDX, wave = tid >> 6, lane = tid & 63, wm = wave >> 1, wn = wave & 1, fr = lane & 15, fq = lane >> 4;
  const int NT = (MODE == 0) ? 28 : 8;
  const bf16_t* A = (MODE == 0) ? rg.xb : p.Tb;
  const int abase = (MODE == 0) ? rg.xbase : 0;
  const bf16_t* Bt = (MODE == 0) ? (p.WinT + (size_t)layer * 3584 * 1024) : (p.WoutT + (size_t)layer * 1024 * 1024);
  const int xcd = blockIdx.x & 7, rgp = xcd >> 2, cgp = xcd & 3;
  const int tm0 = rg.lo >> 8, ntmh = (rg.hi - rg.lo) >> 9;
  const int cpg = (MODE == 0) ? (colset == 0 ? 7 : (colset == 1 ? 6 : 1)) : 2;
  const int nloc = ntmh * cpg;
  for (int q = rg.xr; q < nloc; q += rg.xn) {
    const int tm = tm0 + rgp * ntmh + q / cpg;
    const int tni = cgp * cpg + q % cpg;
    int tn = tni;
    if (MODE == 0 && colset == 1) tn = (tni < 8) ? tni : ((tni < 14) ? tni + 2 : tni + 4);
    if (MODE == 0 && colset == 2) tn = (tni < 2) ? 8 + tni : 14 + tni;
    const bf16_t* Ag = A + (size_t)(tm * 256 - abase) * 1024;
    const bf16_t* Bg = Bt + (size_t)(tn * 128) * 1024;
    f32x4 acc[8][4];
#pragma unroll
    for (int a = 0; a < 8; a++)
#pragma unroll
      for (int b = 0; b < 4; b++) acc[a][b] = (f32x4){0.f, 0.f, 0.f, 0.f};
    const int g_r = lane >> 2, g_c = (lane & 3) * 8;
#define G_GLDS(BUF, K0) { char* As_ = smem + (BUF) * 24576; char* Bs_ = As_ + 16384; \
      _Pragma("unroll") for (int i = 0; i < 4; i++) { const int rr = (wave + i * 4) * 16 + g_r; \
      __builtin_amdgcn_global_load_lds((const unsigned*)(Ag + (size_t)rr * 1024 + (K0) + g_c), (LAS unsigned*)(As_ + (wave + i * 4) * 1024), 16, 0, 0); } \
      _Pragma("unroll") for (int i = 0; i < 2; i++) { const int rr = (wave + i * 4) * 16 + g_r; \
      __builtin_amdgcn_global_load_lds((const unsigned*)(Bg + (size_t)rr * 1024 + (K0) + g_c), (LAS unsigned*)(Bs_ + (wave + i * 4) * 1024), 16, 0, 0); } }
    asm volatile("s_waitcnt vmcnt(0)" ::: "memory");
    G_GLDS(0, 0);
    G_GLDS(1, 32);
    int cur = 0;
    for (int kt = 0; kt < 32; kt++) {
      if (kt < 31) asm volatile("s_waitcnt vmcnt(6)\n\ts_waitcnt lgkmcnt(0)\n\ts_barrier" ::: "memory");
      else asm volatile("s_waitcnt vmcnt(0)\n\ts_waitcnt lgkmcnt(0)\n\ts_barrier" ::: "memory");
      const int nxt2 = (cur == 0) ? 2 : cur - 1;
      const bf16_t* Ac = (const bf16_t*)(smem + cur * 24576);
      const bf16_t* Bc = Ac + 8192;
      bf16x8 af[8], bfr[4];
#pragma unroll
      for (int nt = 0; nt < 4; nt++) bfr[nt] = *(const bf16x8*)(Bc + (wn * 64 + nt * 16 + fr) * 32 + fq * 8);
#pragma unroll
      for (int mt = 7; mt >= 0; mt--) af[mt] = *(const bf16x8*)(Ac + (wm * 128 + mt * 16 + fr) * 32 + fq * 8);
      __builtin_amdgcn_sched_barrier(0);
#pragma unroll
      for (int mt = 0; mt < 8; mt++)
#pragma unroll
        for (int nt = 0; nt < 4; nt++)
          acc[mt][nt] = __builtin_amdgcn_mfma_f32_16x16x32_bf16(bfr[nt], af[mt], acc[mt][nt], 0, 0, 0);
      __builtin_amdgcn_sched_barrier(0);
      if (kt + 2 < 32) G_GLDS(nxt2, (kt + 2) * 32);
      cur = (cur == 2) ? 0 : cur + 1;
    }
    asm volatile("s_waitcnt lgkmcnt(0)\n\ts_barrier" ::: "memory");
#undef G_GLDS
    if (MODE == 0) {
      const int hc = tn * 128 + wn * 64;
      const bool rope = (hc >= 1280 && hc < 1792) || (hc >= 2304 && hc < 2944);
      const float sc = ((hc >= 1280 && hc < 1536) || (hc >= 2304 && hc < 2816)) ? (0.125f * 1.4426950408889634f) : 1.f;
#pragma unroll
      for (int mt = 0; mt < 8; mt++) {
        const int i = tm * 256 + wm * 128 + mt * 16 + fr;
        if (rope) {
          int g = g0 + i, s0, T; seqinfo(g, s0, T); const int t = g - s0;
          const float2* tab = p.ropetab + (size_t)t * 32;
#pragma unroll
          for (int nt = 0; nt < 2; nt++) {
            const float4 cs01 = *(const float4*)(tab + nt * 16 + fq * 4);
            const float4 cs23 = *(const float4*)(tab + nt * 16 + fq * 4 + 2);
            const float cc[4] = {cs01.x, cs01.z, cs23.x, cs23.z};
            const float ss[4] = {cs01.y, cs01.w, cs23.y, cs23.w};
#pragma unroll
            for (int j = 0; j < 4; j++) {
              float x1 = acc[mt][nt][j], x2 = acc[mt][nt + 2][j];
              acc[mt][nt][j] = (x1 * cc[j] - x2 * ss[j]) * sc;
              acc[mt][nt + 2][j] = (x2 * cc[j] + x1 * ss[j]) * sc;
            }
          }
        }
        char* strow = smem + (wm * 128 + mt * 16 + fr) * 272 + (wn * 64 + fq * 4) * 2;
#pragma unroll
        for (int nt = 0; nt < 4; nt++) {
          uint2 o; o.x = cvt_pk_bf16(acc[mt][nt][0], acc[mt][nt][1]); o.y = cvt_pk_bf16(acc[mt][nt][2], acc[mt][nt][3]);
          *(uint2*)(strow + nt * 32) = o;
        }
      }
      __syncthreads();
      {
        const int col0 = tn * 128;
        bf16_t* base; size_t stride;
        if (col0 < 1024) { base = p.Tb + col0; stride = 1024; } else { base = p.proj2 + (col0 - 1024); stride = 2560; }
        const int c16 = tid & 15, r0 = tid >> 4;
#pragma unroll
        for (int i = 0; i < 16; i++) {
          const int row = r0 + i * 16;
          u32x4 v = *(const u32x4*)(smem + row * 272 + c16 * 16);
          *(u32x4*)(base + (size_t)(tm * 256 + row) * stride + c16 * 8) = v;
        }
      }
      __syncthreads();
    } else {
#pragma unroll
      for (int mt = 0; mt < 8; mt++) {
        const int i = tm * 256 + wm * 128 + mt * 16 + fr, g = g0 + i;
        const int col0 = tn * 128 + wn * 64;
        const float* xr = (layer == 0) ? (xrow(p, g) + col0) : (p.out + (size_t)g * DM + col0);
        float* orow = p.out + (size_t)g * DM + col0;
#pragma unroll
        for (int nt = 0; nt < 4; nt++) {
          float4 xv = *(const float4*)(xr + nt * 16 + fq * 4);
          float4 o; o.x = xv.x + acc[mt][nt][0]; o.y = xv.y + acc[mt][nt][1]; o.z = xv.z + acc[mt][nt][2]; o.w = xv.w + acc[mt][nt][3];
          *(float4*)(orow + nt * 16 + fq * 4) = o;
        }
      }
    }
  }
}

__device__ __forceinline__ float shiftv(const bf16_t* tb, int r, int col, float mu) {
  float f = bf2f(tb[(r + 1) * 1024 + col]);
  float pv = bf2f(tb[r * 1024 + col]);
  float nx = bf2f(tb[(r + 2) * 1024 + col]);
  return f + mu * (0.5f * (pv + nx) - f);
}

__device__ __forceinline__ void phase_prep(const Params& p, int layer, int g0, int n, const Rg& rg, char* smem) {
  const int TIDX = opaque_tid();
  bf16_t* linb = (bf16_t*)smem;
  float* zbuf = (float*)(smem + 8704);
  bf16_t* tb = (bf16_t*)(smem + 8704 + 16640);
  const int TT = 16;
  const int c = TIDX, wave = c >> 6;
  const float* mu = p.mu + layer * 1024;
  const float mu_r = mu[c], mu_k = mu[256 + c], mu_v = mu[512 + c], mu_l = mu[768 + c];
  const float kkc = p.k_k[layer * 256 + c], kac = p.k_a[layer * 256 + c], rkc = p.r_k[layer * 256 + c];
  const float w0f = p.w0[(layer * 2 + 0) * 256 + c], w0b = p.w0[(layer * 2 + 1) * 256 + c];
  const float a0f = p.a0[(layer * 2 + 0) * 256 + c], a0b = p.a0[(layer * 2 + 1) * 256 + c];
  const uint2* lwp = p.lw + (size_t)layer * 64 * 256 + c;
  const float* w2f = p.w2 + (size_t)((layer * 2 + 0) * 64) * 256 + c;
  const float* w2b = p.w2 + (size_t)((layer * 2 + 1) * 64) * 256 + c;
  const float* a2f = p.a2 + (size_t)((layer * 2 + 0) * 64) * 256 + c;
  const float* a2b = p.a2 + (size_t)((layer * 2 + 1) * 64) * 256 + c;
  const size_t PS = (size_t)n * 256;
  bf16_t* Pv = p.PX;
  for (int tile = (rg.lo >> 4) + rg.br; tile < (rg.hi >> 4); tile += rg.nb) {
    const int i0 = tile * TT;
    {
      int g = g0 + i0, s0, T; seqinfo(g, s0, T); int t0 = g - s0;
#pragma unroll
      for (int q = 0; q < 9; q++) {
        int ch = c + q * 256;
        int r = ch >> 7, cc = ch & 127;
        int t = t0 - 1 + r;
        u32x4 v = (u32x4){0u, 0u, 0u, 0u};
        if (t >= 0 && t < T) v = *(const u32x4*)(p.Tb + (size_t)(i0 - 1 + r) * 1024 + cc * 8);
        *(u32x4*)(tb + r * 1024 + cc * 8) = v;
      }
    }
    __syncthreads();
#pragma unroll 4
    for (int tk = 0; tk < TT; tk++) {
      float sh = shiftv(tb, tk, 768 + c, mu_l);
      if (c < 128) { float e2 = __expf(2.f * sh); sh = 1.f - 2.f / (e2 + 1.f); }
      linb[tk * 272 + c] = f2bf(sh);
    }
    __syncthreads();
    float zwf[TT], zwb[TT], zaf[TT], zab[TT];
#pragma unroll
    for (int tk = 0; tk < TT; tk++) { zwf[tk] = w0f; zwb[tk] = w0b; zaf[tk] = a0f; zab[tk] = a0b; }
    {
      const int lane = c & 63, fr = lane & 15, fq = lane >> 4;
#pragma unroll
      for (int gq = 0; gq < 4; gq++) {
        f32x4 acc[4];
#pragma unroll
        for (int nt = 0; nt < 4; nt++) acc[nt] = (f32x4){0.f, 0.f, 0.f, 0.f};
#pragma unroll
        for (int ks = 0; ks < 2; ks++) {
          bf16x8 av = *(const bf16x8*)(linb + fr * 272 + gq * 64 + ks * 32 + fq * 8);
#pragma unroll
          for (int nt = 0; nt < 4; nt++) {
            bf16x8 bv = *(const bf16x8*)(p.lwT + ((size_t)((layer * 4 + gq) * 256 + wave * 64 + nt * 16 + fr)) * 64 + ks * 32 + fq * 8);
            acc[nt] = __builtin_amdgcn_mfma_f32_16x16x32_bf16(av, bv, acc[nt], 0, 0, 0);
          }
        }
#pragma unroll
        for (int nt = 0; nt < 4; nt++)
#pragma unroll
          for (int jx = 0; jx < 4; jx++) zbuf[(fq * 4 + jx) * 260 + wave * 64 + nt * 16 + fr] = acc[nt][jx];
        __syncthreads();
#pragma unroll
        for (int tk = 0; tk < TT; tk++) {
          float zv = zbuf[tk * 260 + c];
          if (gq == 0) zwf[tk] += zv; else if (gq == 1) zwb[tk] += zv; else if (gq == 2) zaf[tk] += zv; else zab[tk] += zv;
        }
        __syncthreads();
      }
    }
    float gf[TT], gb[TT];
#pragma unroll
    for (int tk = 0; tk < TT; tk++) {
#pragma unroll
      for (int e = 0; e < 2; e++) {
        float nz = -(e ? zwb[tk] : zwf[tk]);
        float sp = fmaxf(nz, 0.f) + __logf(1.f + __expf(-fabsf(nz)));
        float dec = __expf(-__expf(-sp - 0.5f));
        if (e) gb[tk] = dec; else gf[tk] = dec;
      }
    }
#pragma unroll
    for (int tk = 1; tk < TT; tk++) gf[tk] *= gf[tk - 1];
#pragma unroll
    for (int tk = TT - 2; tk >= 0; tk--) gb[tk] *= gb[tk + 1];
    p.g16[(size_t)tile * 512 + c] = gf[TT - 1];
    p.g16[(size_t)tile * 512 + 256 + c] = gb[0];
#pragma unroll
    for (int tk = 0; tk < TT; tk++) {
      int i = i0 + tk;
      float r = shiftv(tb, tk, c, mu_r);
      float k = shiftv(tb, tk, 256 + c, mu_k);
      float v = shiftv(tb, tk, 512 + c, mu_v);
      float kk = k * kkc;
      float ss = wave_sum_fast(kk * kk);
      kk = kk / fmaxf(sqrtf(ss), 1e-12f);
      float keffsum = 0.f;
#pragma unroll
      for (int e = 0; e < 2; e++) {
        float za = e ? zab[tk] : zaf[tk];
        float a = 1.f / (1.f + __expf(-za));
        float keff = k * (1.f + (a - 1.f) * kac);
        float b = kk * a;
        keffsum += keff;
        float gcur = e ? gb[tk] : gf[tk];
        float gprev = e ? (tk < TT - 1 ? gb[tk + 1] : 1.f) : (tk > 0 ? gf[tk - 1] : 1.f);
        float ginv = 1.f / gcur;
        unsigned* b32 = (unsigned*)(p.PX + (size_t)(1 + 4 * e) * PS);
        b32[(size_t)i * 256 + c] = cvt_pk_bf16(kk * gprev, r * gcur);
        b32[PS + (size_t)i * 256 + c] = cvt_pk_bf16(keff * ginv, b * ginv);
      }
      float bon = wave_sum_fast(r * keffsum * rkc);
      if ((c & 63) == 0) p.bonus[i * 4 + wave] = bon;
      Pv[(size_t)i * 256 + c] = f2bf(v);
    }
    __syncthreads();
  }
}

__device__ __forceinline__ void scan_item(const Params& p, int n, int iS, int T, int h, int e, int rg, char* smem) {
  const int TIDX = opaque_tid();
  const int TC = 16, RS = 256, BUFS = TC * 256 + 256;
  float* buf = (float*)smem;
  float* yS = buf + 2 * BUFS;
  const int tid = TIDX, wave = tid >> 6, lane = tid & 63, rl = wave * 4 + (lane >> 4), cs = lane & 15;
  const size_t PS = (size_t)n * 256;
  const bf16_t* Pv = p.PX;
  const unsigned* PAR = (const unsigned*)(p.PX + (size_t)(1 + 4 * e) * PS); const unsigned* PKB = PAR + PS;
  bf16_t* ydst = e ? p.yb : p.yf;
  const int nch = T / TC;
  const int ss = tid >> 4, jj = tid & 15;
  u32x4 rAR, rKB; bf16_t rv; f32x4 g16n;
#define SCAN_PREFETCH(CK) { int step = (CK) * TC + ss; int i = iS + (e ? (T - 1 - step) : step); \
    size_t o = (size_t)i * 256 + h * 64 + jj * 4; \
    rAR = *(const u32x4*)(PAR + o); rKB = *(const u32x4*)(PKB + o); \
    rv = Pv[(size_t)i * 256 + h * 64 + rg * 16 + jj]; \
    int tl = (iS + (e ? (T - TC * ((CK) + 1)) : (CK) * TC)) >> 4; \
    g16n = *(const f32x4*)(p.g16 + (size_t)tl * 512 + e * 256 + h * 64 + cs * 4); }
#define UNPK2(dst, src, OLO, OHI) { float4 f, g_; f.x = __uint_as_float(src.x << 16); f.y = __uint_as_float(src.y << 16); \
    f.z = __uint_as_float(src.z << 16); f.w = __uint_as_float(src.w << 16); \
    g_.x = __uint_as_float(src.x & 0xffff0000u); g_.y = __uint_as_float(src.y & 0xffff0000u); \
    g_.z = __uint_as_float(src.z & 0xffff0000u); g_.w = __uint_as_float(src.w & 0xffff0000u); \
    *(float4*)(dst + OLO + jj * 4) = f; *(float4*)(dst + OHI + jj * 4) = g_; }
#define UNPK(dst, src, OFS) { float4 f; f.x = __uint_as_float(src.x << 16); f.y = __uint_as_float(src.x & 0xffff0000u); \
    f.z = __uint_as_float(src.y << 16); f.w = __uint_as_float(src.y & 0xffff0000u); *(float4*)(dst + OFS + jj * 4) = f; }
  SCAN_PREFETCH(0);
  if (T > 8192) __builtin_amdgcn_s_setprio(3); else __builtin_amdgcn_s_setprio(2);
  f32x2 Xa = (f32x2){0.f, 0.f}, Xb = (f32x2){0.f, 0.f};
  for (int ck = 0; ck < nch; ck++) {
    float* B = buf + (ck & 1) * BUFS;
    {
      float* q = B + ss * RS;
      UNPK2(q, rAR, 0, 64);
      UNPK2(q, rKB, 128, 192);
      B[TC * 256 + jj * 16 + ss] = bf2f(rv);
    }
    const f32x4 g16 = g16n;
    __syncthreads();
    if (ck + 1 < nch) SCAN_PREFETCH(ck + 1);
    float yp[TC];
    f32x4 Aq[3], Rq[3], Kq[3], Bq[3];
    f32x4 v4[4];
#pragma unroll
    for (int q4 = 0; q4 < 4; q4++) v4[q4] = *(const f32x4*)(B + TC * 256 + rl * 16 + q4 * 4);
#define SCAN_LD(S) { const float* q_ = B + (S) * 256; Aq[(S) % 3] = *(const f32x4*)(q_ + cs * 4); Rq[(S) % 3] = *(const f32x4*)(q_ + 64 + cs * 4); \
      Kq[(S) % 3] = *(const f32x4*)(q_ + 128 + cs * 4); Bq[(S) % 3] = *(const f32x4*)(q_ + 192 + cs * 4); }
    SCAN_LD(0); SCAN_LD(1);
#pragma unroll
    for (int s = 0; s < TC; s++) {
      if (s + 2 < TC) SCAN_LD(s + 2);
      f32x4 A = Aq[s % 3], Rr = Rq[s % 3], K = Kq[s % 3], Bv = Bq[s % 3];
      float v = v4[s >> 2][s & 3];
      f32x2 vv = (f32x2){v, v};
      f32x2 pp2 = __builtin_elementwise_fma(Xb, A.zw, Xa * A.xy);
      f32x2 Ua = __builtin_elementwise_fma(vv, K.xy, Xa);
      f32x2 Ub = __builtin_elementwise_fma(vv, K.zw, Xb);
      float pp = red16(pp2.x + pp2.y);
      f32x2 nu = (f32x2){-pp, -pp};
      Xa = __builtin_elementwise_fma(nu, Bv.xy, Ua);
      Xb = __builtin_elementwise_fma(nu, Bv.zw, Ub);
      f32x2 yy2 = __builtin_elementwise_fma(Xb, Rr.zw, Xa * Rr.xy);
      yp[s] = yy2.x + yy2.y;
    }
#undef SCAN_LD
    float ykeep;
    {
      const bool b3 = (cs & 8) != 0, b2 = (cs & 4) != 0, b1 = (cs & 2) != 0, b0 = (cs & 1) != 0;
      float a8[8], a4[4], a2[2];
#pragma unroll
      for (int s = 0; s < 8; s++) { float lo = yp[s], hi = yp[s + 8]; a8[s] = (b3 ? hi : lo) + dpp_get<0x140>(b3 ? lo : hi); }
#pragma unroll
      for (int s = 0; s < 4; s++) { float lo = a8[s], hi = a8[s + 4]; a4[s] = (b2 ? hi : lo) + dpp_get<0x141>(b2 ? lo : hi); }
#pragma unroll
      for (int s = 0; s < 2; s++) { float lo = a4[s], hi = a4[s + 2]; a2[s] = (b1 ? hi : lo) + dpp_get<0x4E>(b1 ? lo : hi); }
      { float lo = a2[0], hi = a2[1]; ykeep = (b0 ? hi : lo) + dpp_get<0xB1>(b0 ? lo : hi); }
    }
    Xa = Xa * g16.xy; Xb = Xb * g16.zw;
    yS[cs * 16 + rl] = ykeep;
    __syncthreads();
    {
      int step = ck * TC + ss; int i = iS + (e ? (T - 1 - step) : step);
      ydst[(size_t)i * 256 + h * 64 + rg * 16 + jj] = f2bf(yS[ss * 16 + jj]);
    }
  }
  __builtin_amdgcn_s_setprio(0);
#undef SCAN_PREFETCH
#undef UNPK
#undef UNPK2
}

#define LOG2E 1.4426950408889634f
#define LN2 0.6931471805599453f

template <bool IS_C>
__device__ __forceinline__ void attn_unit(const Params& p, int layer, int g0, int n, int unit, char* smem, int tid) {
  constexpr int NK = IS_C ? 288 : 192;
  constexpr int NT = IS_C ? 18 : 10;
  constexpr int VS = IS_C ? 304 : 208;
  constexpr int R = IS_C ? 128 : 64;
  bf16_t* Ks = (bf16_t*)smem;
  bf16_t* Vt = Ks + NK * 64;
  const int wave = tid >> 6, lane = tid & 63, fr = lane & 15, fq = lane >> 4;
  int dil, ibase, klo, khi, kcol, vcol, qcol, iq, wst, doff, br = 0, h = 0, hq = 0;
  if (IS_C) {
    int hk = unit & 1, ct = unit >> 1;
    int i0 = ct * 16, g = g0 + i0, s0, T; seqinfo(g, s0, T); int t0 = g - s0;
    dil = 1; ibase = i0 - 128;
    klo = max(0, 128 - t0); khi = min(NK, T - t0 + 128);
    kcol = 1792 + hk * 64; vcol = 1920 + hk * 64;
    hq = hk * 4 + wave; qcol = 1280 + hq * 64; iq = i0 + fr;
    wst = 0; doff = 128;
  } else {
    const int per = n >> 6;
    int bh = unit / per, u = unit - bh * per;
    br = bh >> 2; h = bh & 3;
    dil = br == 0 ? 1 : (br == 1 ? 4 : 16);
    int bidx = u / dil, res = u - bidx * dil;
    int S0 = bidx * 64 * dil, g = g0 + S0, s0, T; seqinfo(g, s0, T); int tS = g - s0;
    int qi0 = tS / dil, L = T / dil;
    ibase = S0 + res - 64 * dil;
    klo = max(0, 64 - qi0); khi = min(NK, L - qi0 + 64);
    kcol = 512 + h * 64; vcol = 768 + h * 64; qcol = 256 + h * 64;
    iq = S0 + res + (wave * 16 + fr) * dil;
    wst = (wave >> 1) * 32; doff = 64 + wave * 16;
  }
#pragma unroll 3
  for (int ch = tid; ch < NK * 8; ch += 256) {
    int key = ch >> 3, c8 = ch & 7;
    bool ok = key >= klo && key < khi;
    u32x4 kv = (u32x4){0u, 0u, 0u, 0u}, vv = (u32x4){0u, 0u, 0u, 0u};
    if (ok) {
      const bf16_t* rowp = p.proj2 + (size_t)(ibase + key * dil) * 2560;
      kv = *(const u32x4*)(rowp + kcol + c8 * 8);
      vv = *(const u32x4*)(rowp + vcol + c8 * 8);
    }
    *(u32x4*)(Ks + key * 64 + ((c8 ^ (key & 7)) * 8)) = kv;
    int pos = (key & ~31) | (((key >> 2) & 3) << 3) | (((key >> 4) & 1) << 2) | (key & 3);
    bf16_t* vd = Vt + (c8 * 8) * VS + pos;
    vd[0 * VS] = (bf16_t)(vv.x & 0xffffu); vd[1 * VS] = (bf16_t)(vv.x >> 16);
    vd[2 * VS] = (bf16_t)(vv.y & 0xffffu); vd[3 * VS] = (bf16_t)(vv.y >> 16);
    vd[4 * VS] = (bf16_t)(vv.z & 0xffffu); vd[5 * VS] = (bf16_t)(vv.z >> 16);
    vd[6 * VS] = (bf16_t)(vv.w & 0xffffu); vd[7 * VS] = (bf16_t)(vv.w >> 16);
  }
  const bf16_t* qrow = p.proj2 + (size_t)iq * 2560 + qcol;
  bf16x8 bq0 = *(const bf16x8*)(qrow + fq * 8);
  bf16x8 bq1 = *(const bf16x8*)(qrow + 32 + fq * 8);
  __syncthreads();
  f32x4 s[NT];
#pragma unroll
  for (int mt = 0; mt < NT; mt++) {
    int key = wst + mt * 16 + fr;
    const bf16_t* kr = Ks + key * 64;
    bf16x8 a0 = *(const bf16x8*)(kr + ((fq ^ (key & 7)) * 8));
    bf16x8 a1 = *(const bf16x8*)(kr + (((4 + fq) ^ (key & 7)) * 8));
    f32x4 acc = (f32x4){0.f, 0.f, 0.f, 0.f};
    acc = __builtin_amdgcn_mfma_f32_16x16x32_bf16(a0, bq0, acc, 0, 0, 0);
    acc = __builtin_amdgcn_mfma_f32_16x16x32_bf16(a1, bq1, acc, 0, 0, 0);
    s[mt] = acc;
  }
  const int lo_c = max(klo, doff + fr - R), hi_c = min(khi - 1, doff + fr + R);
  float mx = -1e30f;
#pragma unroll
  for (int mt = 0; mt < NT; mt++)
#pragma unroll
    for (int j = 0; j < 4; j++) {
      int kap = wst + mt * 16 + fq * 4 + j;
      bool v = kap >= lo_c && kap <= hi_c;
      float sv = v ? s[mt][j] : -1e30f;
      s[mt][j] = sv;
      mx = fmaxf(mx, sv);
    }
  mx = fmaxf(mx, __shfl_xor(mx, 16));
  mx = fmaxf(mx, __shfl_xor(mx, 32));
  float sink2 = 0.f;
  if (IS_C) { sink2 = p.sink[layer * 8 + hq] * LOG2E; mx = fmaxf(mx, sink2); }
  float sum = 0.f;
  unsigned pk[NT / 2][4];
#pragma unroll
  for (int mt = 0; mt < NT; mt++) {
    float p0 = exp2f(s[mt][0] - mx), p1 = exp2f(s[mt][1] - mx), p2 = exp2f(s[mt][2] - mx), p3 = exp2f(s[mt][3] - mx);
    sum += (p0 + p1) + (p2 + p3);
    pk[mt >> 1][(mt & 1) * 2 + 0] = cvt_pk_bf16(p0, p1);
    pk[mt >> 1][(mt & 1) * 2 + 1] = cvt_pk_bf16(p2, p3);
  }
  sum += __shfl_xor(sum, 16);
  sum += __shfl_xor(sum, 32);
  if (IS_C) sum += exp2f(sink2 - mx);
  f32x4 o[4];
#pragma unroll
  for (int dt = 0; dt < 4; dt++) o[dt] = (f32x4){0.f, 0.f, 0.f, 0.f};
#pragma unroll
  for (int u = 0; u < NT / 2; u++) {
    u32x4 pb = (u32x4){pk[u][0], pk[u][1], pk[u][2], pk[u][3]};
    bf16x8 bfrag = __builtin_bit_cast(bf16x8, pb);
#pragma unroll
    for (int dt = 0; dt < 4; dt++) {
      bf16x8 a = *(const bf16x8*)(Vt + (dt * 16 + fr) * VS + wst + u * 32 + fq * 8);
      o[dt] = __builtin_amdgcn_mfma_f32_16x16x32_bf16(a, bfrag, o[dt], 0, 0, 0);
    }
  }
  const float inv = 1.f / sum;
  if (IS_C) {
    const bf16_t* grow = p.proj2 + (size_t)iq * 2560 + 2048 + hq * 64;
    bf16_t* orow = p.Tb + (size_t)iq * 1024 + 512 + hq * 64;
#pragma unroll
    for (int dt = 0; dt < 4; dt++) {
      uint2 gg = *(const uint2*)(grow + dt * 16 + fq * 4);
      float g0f = __uint_as_float(gg.x << 16), g1f = __uint_as_float(gg.x & 0xffff0000u);
      float g2f = __uint_as_float(gg.y << 16), g3f = __uint_as_float(gg.y & 0xffff0000u);
      uint2 ov;
      ov.x = cvt_pk_bf16(o[dt][0] * inv * silu(g0f), o[dt][1] * inv * silu(g1f));
      ov.y = cvt_pk_bf16(o[dt][2] * inv * silu(g2f), o[dt][3] * inv * silu(g3f));
      *(uint2*)(orow + dt * 16 + fq * 4) = ov;
    }
  } else {
    bf16_t* orow = p.obuf + ((size_t)br * n + iq) * 256 + h * 64;
#pragma unroll
    for (int dt = 0; dt < 4; dt++) {
      uint2 ov;
      ov.x = cvt_pk_bf16(o[dt][0] * inv, o[dt][1] * inv);
      ov.y = cvt_pk_bf16(o[dt][2] * inv, o[dt][3] * inv);
      *(uint2*)(orow + dt * 16 + fq * 4) = ov;
    }
    if (fq == 0) p.lse[((size_t)br * n + iq) * 4 + h] = (mx + __log2f(sum)) * LN2;
  }
  __syncthreads();
}

__device__ __forceinline__ void attn_items(const Params& p, int layer, int g0, int n, int first_blk, int nblk, char* smem, int vb) {
  const int TIDX = opaque_tid();
  const int nC = 2 * (n >> 4), nB = 12 * (n >> 6);
  int it = vb - first_blk;
  for (; it < nC; it += nblk) attn_unit<true>(p, layer, g0, n, it, smem, TIDX);
  for (it -= nC; it < nB; it += nblk) attn_unit<false>(p, layer, g0, n, it, smem, TIDX);
}

__device__ __forceinline__ int mix_vb(int nscan_blk) {
  const int G = gridDim.x, half = G >> 1;
  const int b = blockIdx.x;
  if ((G & 1) == 0 && nscan_blk <= half) {
    if (b < nscan_blk) return b;
    return b;
  }
  return b;
}
__device__ __forceinline__ void mix_counts(int g0, int n, int& nP, int& nS, int& gP0, int& gS0) {
  gP0 = g0; int gP1 = min(g0 + n, 32768); nP = gP1 > gP0 ? (gP1 - gP0) / 8192 : 0;
  gS0 = max(g0, 32768); int gS1 = g0 + n; nS = gS1 > gS0 ? (gS1 - gS0) / 16384 : 0;
}
__device__ __forceinline__ void phase_mix(const Params& p, int layer, int g0, int n, char* smem, int iso_lo, int iso_n) {
  int nP, nS, gP0, gS0; mix_counts(g0, n, nP, nS, gP0, gS0);
  const int nitems = (nP + nS) * 32;
  const int nscan_blk = min(nitems, (int)gridDim.x / 2);
  const int vb = mix_vb(nscan_blk);
  if (vb < nscan_blk) {
    for (int it = vb; it < nitems; it += nscan_blk) {
      int sq, rem, iS, T;
      if (it < nS * 32) { sq = it / 32; rem = it % 32; iS = (gS0 - g0) + sq * 16384; T = 16384; }
      else { int j = it - nS * 32; sq = j / 32; rem = j % 32; iS = (gP0 - g0) + sq * 8192; T = 8192; }
      int h = rem >> 3, e = (rem >> 2) & 1, rg = rem & 3;
      __syncthreads();
      scan_item(p, n, iS, T, h, e, rg, smem);
    }
  } else {
    const int b = blockIdx.x;
    if (iso_n > 0) {
      if (b >= iso_lo && b < iso_lo + iso_n) return;
      const int r = (b < iso_lo) ? (b - nscan_blk) : (b - nscan_blk - iso_n);
      attn_items(p, layer, g0, n, 0, gridDim.x - nscan_blk - iso_n, smem, r);
    } else attn_items(p, layer, g0, n, nscan_blk, gridDim.x - nscan_blk, smem, vb);
  }
}

__device__ __forceinline__ float bflo(unsigned w) { return __uint_as_float(w << 16); }
__device__ __forceinline__ float bfhi(unsigned w) { return __uint_as_float(w & 0xffff0000u); }
__device__ __forceinline__ void phase_fina(const Params& p, int layer, int g0, int n, const Rg& rg) {
  const int TIDX = opaque_tid();
  const int h2 = TIDX & 127, c2 = h2 * 2, tsel = TIDX >> 7, head = h2 >> 5;
  const float2 lw = *(const float2*)(p.ln_w + layer * 256 + c2), lb = *(const float2*)(p.ln_b + layer * 256 + c2);
  const bf16_t* Pv = p.PX;
  const int UN = 4;
  for (int i0 = rg.lo + rg.br * (2 * UN); i0 < rg.hi; i0 += rg.nb * (2 * UN)) {
    unsigned yf[UN], yb[UN], pv[UN], ga[UN], gbv[UN], o0[UN], o1[UN], o2[UN];
    float bonv[UN], l0[UN], l1[UN], l2[UN];
#pragma unroll
    for (int u = 0; u < UN; u++) {
      const size_t i = i0 + u * 2 + tsel;
      yf[u] = *(const unsigned*)(p.yf + i * 256 + c2); yb[u] = *(const unsigned*)(p.yb + i * 256 + c2);
      pv[u] = *(const unsigned*)(Pv + i * 256 + c2); bonv[u] = p.bonus[i * 4 + head];
      ga[u] = *(const unsigned*)(p.proj2 + i * 2560 + c2); gbv[u] = *(const unsigned*)(p.proj2 + i * 2560 + 1024 + c2);
      l0[u] = p.lse[((size_t)0 * n + i) * 4 + head]; l1[u] = p.lse[((size_t)1 * n + i) * 4 + head]; l2[u] = p.lse[((size_t)2 * n + i) * 4 + head];
      o0[u] = *(const unsigned*)(p.obuf + ((size_t)0 * n + i) * 256 + c2); o1[u] = *(const unsigned*)(p.obuf + ((size_t)1 * n + i) * 256 + c2);
      o2[u] = *(const unsigned*)(p.obuf + ((size_t)2 * n + i) * 256 + c2);
    }
#pragma unroll
    for (int u = 0; u < UN; u++) {
      const size_t i = i0 + u * 2 + tsel;
      const float y0 = bflo(yf[u]) + bflo(yb[u]), y1 = bfhi(yf[u]) + bfhi(yb[u]);
      float s = xrow16_sum(red16(y0 + y1));
      const float mean = s * (1.f / 64.f);
      const float d0 = y0 - mean, d1 = y1 - mean;
      float q = xrow16_sum(red16(d0 * d0 + d1 * d1));
      const float rs = rsqrtf(q * (1.f / 64.f) + 64e-5f);
      const float a0 = (d0 * rs * lw.x + lb.x + bonv[u] * bflo(pv[u])) * silu(bflo(ga[u]));
      const float a1 = (d1 * rs * lw.y + lb.y + bonv[u] * bfhi(pv[u])) * silu(bfhi(ga[u]));
      *(unsigned*)(p.Tb + i * 1024 + c2) = cvt_pk_bf16(a0, a1);
      const float lm = fmaxf(l0[u], fmaxf(l1[u], l2[u]));
      const float e0 = __expf(l0[u] - lm), e1 = __expf(l1[u] - lm), e2 = __expf(l2[u] - lm);
      const float inv = 1.f / (e0 + e1 + e2);
      const float b0 = (e0 * bflo(o0[u]) + e1 * bflo(o1[u]) + e2 * bflo(o2[u])) * inv * silu(bflo(gbv[u]));
      const float b1 = (e0 * bfhi(o0[u]) + e1 * bfhi(o1[u]) + e2 * bfhi(o2[u])) * inv * silu(bfhi(gbv[u]));
      *(unsigned*)(p.Tb + i * 1024 + 256 + c2) = cvt_pk_bf16(b0, b1);
    }
  }
}

__device__ __forceinline__ void phase_fnorm(const Params& p, int g0, const Rg& rg) {
  const int TIDX = opaque_tid();
  int wave = TIDX >> 6, lane = TIDX & 63;
  const float4* gam = (const float4*)p.final_g;
  for (int i = rg.lo + rg.br * 4 + wave; i < rg.hi; i += rg.nb * 4) {
    float4* xr = (float4*)(p.out + (size_t)(g0 + i) * DM);
    float4 v[4]; float ss = 0.f;
#pragma unroll
    for (int q = 0; q < 4; q++) { v[q] = xr[q * 64 + lane]; ss += v[q].x * v[q].x + v[q].y * v[q].y + v[q].z * v[q].z + v[q].w * v[q].w; }
    ss = wave_sum(ss);
    float rstd = rsqrtf(ss * (1.f / 1024.f) + 1e-5f);
#pragma unroll
    for (int q = 0; q < 4; q++) {
      float4 gg = gam[q * 64 + lane];
      float4 o; o.x = v[q].x * rstd * gg.x; o.y = v[q].y * rstd * gg.y; o.z = v[q].z * rstd * gg.z; o.w = v[q].w * rstd * gg.w;
      xr[q * 64 + lane] = o;
    }
  }
}

__global__ void __launch_bounds__(256, 2) mega(Params p, int ph_lo, int ph_hi) {
  __shared__ __attribute__((aligned(16))) char smem[SMEM_BYTES];
  __shared__ uint4 xb_words;
  __shared__ uint4 xb_words2;
  if (threadIdx.x == 0) { xb_words = make_uint4(0u, 0u, 0u, 0u); xb_words2 = make_uint4(0u, 0u, 0u, 0u); }
  __syncthreads();
  const int n = p.ntok_pass;
  int nP, nS, gP0, gS0; mix_counts(0, n, nP, nS, gP0, gS0);
  const int nitems = (nP + nS) * 32;
  const int nscan_blk = min(nitems, (int)gridDim.x / 2);
  const int nsamp = nS * 32;
  const bool overlap = (p.npass == 1) && (nscan_blk == nitems) && nS > 0 && nP > 0 && ((gridDim.x & 7) == 0) && ((nsamp & 7) == 0) && (nsamp <= (nscan_blk >> 1));
  const int vb = mix_vb(nscan_blk);
  const bool sscan = overlap && (vb < nsamp);
  const int snb = (int)gridDim.x - nsamp, srank = vb - nsamp, half_g = (int)gridDim.x >> 1;
  XcdBarrier xb = xcd_barrier_post(p.bar, (volatile LAS unsigned*)&xb_words, gridDim.x, true);
  XcdBarrier xs = xcd_barrier_post(p.bar + 4096, (volatile LAS unsigned*)&xb_words2, (unsigned)snb, overlap && !sscan);
  const int NSTEP = overlap ? 22 : (ph_hi - ph_lo);
  int st0 = 0;
  if (overlap || ph_lo == 0) {
    phase_wconv(p, smem);
    if (overlap) {
      Rg rg; rg.lo = 0; rg.hi = n; rg.br = blockIdx.x; rg.nb = gridDim.x; rg.xb = p.PX; rg.xbase = 0; rg.xr = blockIdx.x >> 3; rg.xn = gridDim.x >> 3;
      phase_xnorm(p, 0, 0, rg);
    }
    if (overlap || 1 < ph_hi) xcd_barrier(xb);
    st0 = overlap ? 2 : 1;
  }
  for (int st = st0; st < NSTEP; st++) {
    int op, layer, rsel, who, bar, g0 = 0, colset = 0;
    if (overlap) {
      switch (st) {
        case 1:  op = 1; layer = 0; rsel = 0; who = 0; bar = 1; break;
        case 2:  op = 2; layer = 0; rsel = 0; who = 0; bar = 1; break;
        case 3:  op = 3; layer = 0; rsel = 0; who = 0; bar = 1; break;
        case 4:  op = 4; layer = 0; rsel = 0; who = 0; bar = 2; break;
        case 5:  op = 5; layer = 0; rsel = 1; who = 1; bar = 2; break;
        case 6:  op = 6; layer = 0; rsel = 1; who = 1; bar = 2; break;
        case 7:  op = 1; layer = 1; rsel = 1; who = 1; bar = 2; break;
        case 8:  op = 2; layer = 1; rsel = 1; who = 1; bar = 1; colset = 1; break;
        case 9:  op = 5; layer = 0; rsel = 2; who = 0; bar = 1; break;
        case 10: op = 6; layer = 0; rsel = 2; who = 0; bar = 1; break;
        case 11: op = 1; layer = 1; rsel = 2; who = 0; bar = 1; break;
        case 12: op = 2; layer = 1; rsel = 2; who = 0; bar = 1; break;
        case 13: op = 3; layer = 1; rsel = 0; who = 0; bar = 1; break;
        case 14: op = 4; layer = 1; rsel = 0; who = 0; bar = 2; break;
        case 15: op = 2; layer = 1; rsel = 1; who = 1; bar = 2; colset = 2; break;
        case 16: op = 5; layer = 1; rsel = 1; who = 1; bar = 2; break;
        case 17: op = 6; layer = 1; rsel = 1; who = 1; bar = 2; break;
        case 18: op = 7; layer = 1; rsel = 1; who = 1; bar = 1; break;
        case 19: op = 5; layer = 1; rsel = 2; who = 0; bar = 1; break;
        case 20: op = 6; layer = 1; rsel = 2; who = 0; bar = 1; break;
        default: op = 7; layer = 1; rsel = 2; who = 0; bar = 0; break;
      }
    } else {
      const int ph = ph_lo + st;
      rsel = 0; who = 0; bar = (ph + 1 < ph_hi) ? 1 : 0; layer = 0;
      if (ph == 0) op = 0;
      else {
        int q = ph - 1, pass = q / 13, r = q % 13;
        g0 = pass * n;
        if (r == 12) op = 7;
        else { layer = r / 6; int s = r % 6; op = (s == 0) ? 1 : (s == 1) ? 2 : (s == 2) ? 3 : (s == 3) ? 4 : (s == 4) ? 5 : 6; }
      }
    }
    const bool iso = overlap && (st >= 14) && (st <= 18);
    const bool partner = ((int)blockIdx.x >= half_g) && ((int)blockIdx.x < half_g + nsamp);
    if (!(who == 1 && sscan) && !(iso && partner && who == 1)) {
      Rg rg;
      if (rsel == 0) { rg.lo = 0; rg.hi = n; rg.br = blockIdx.x; rg.nb = gridDim.x; rg.xb = p.PX; rg.xbase = 0; rg.xr = blockIdx.x >> 3; rg.xn = gridDim.x >> 3; }
      else if (rsel == 1) {
        rg.lo = 0; rg.hi = 32768; rg.xb = p.xb2; rg.xbase = 0;
        if (iso) {
          const int bb = (int)blockIdx.x - nsamp - (((int)blockIdx.x >= half_g + nsamp) ? nsamp : 0);
          rg.br = bb; rg.nb = snb - nsamp; rg.xr = bb >> 3; rg.xn = (snb - nsamp) >> 3;
        } else { rg.br = srank; rg.nb = snb; rg.xr = ((int)blockIdx.x - nsamp) >> 3; rg.xn = snb >> 3; }
      }
      else { rg.lo = 32768; rg.hi = n; rg.br = blockIdx.x; rg.nb = gridDim.x; rg.xb = p.obuf; rg.xbase = 32768; rg.xr = blockIdx.x >> 3; rg.xn = gridDim.x >> 3; }
      switch (op) {
        case 1: phase_xnorm(p, layer, g0, rg); break;
        case 2: phase_gemm<0>(p, layer, g0, rg, smem, colset); break;
        case 3: phase_prep(p, layer, g0, n, rg, smem); break;
        case 4: phase_mix(p, layer, g0, n, smem, half_g, iso ? nsamp : 0); break;
        case 5: phase_fina(p, layer, g0, n, rg); break;
        case 6: phase_gemm<1>(p, layer, g0, rg, smem, 0); break;
        default: phase_fnorm(p, g0, rg); break;
      }
    }
    if (bar == 1) { if (ph_hi < 0) cg::this_grid().sync(); else xcd_barrier(xb); }
    else if (bar == 2 && !sscan) xcd_barrier(xs);
  }
}

__global__ void noop_kernel(int* x) { if (x == nullptr && threadIdx.x == 12345) *x = 0; }

extern "C" void kernel_launch(void* const* d_in, const int* in_sizes, int n_in, void* d_out, int out_size, void* d_ws,
                              size_t ws_size, hipStream_t stream) {
  static int grid_blocks = 0;
  if (!grid_blocks) {
    int dev = 0, cus = 0, per_cu = 0;
    hipGetDevice(&dev);
    hipDeviceGetAttribute(&cus, hipDeviceAttributeMultiprocessorCount, dev);
    hipOccupancyMaxActiveBlocksPerMultiprocessor(&per_cu, mega, 256, 0);
    if (per_cu > 2) per_cu = 2;
    if (per_cu < 1) per_cu = 1;
    grid_blocks = (cus * per_cu) & ~7;
  }
  Params p;
  memset((void*)&p, 0, sizeof(p));
  p.xin0 = (const float*)d_in[0]; p.xin1 = (const float*)d_in[1];
  p.norm_g = (const float*)d_in[2]; p.w_in = (const float*)d_in[3]; p.mu = (const float*)d_in[4];
  p.w0 = (const float*)d_in[5]; p.w2 = (const float*)d_in[6]; p.a0 = (const float*)d_in[7]; p.a2 = (const float*)d_in[8];
  p.k_k = (const float*)d_in[9]; p.k_a = (const float*)d_in[10]; p.r_k = (const float*)d_in[11];
  p.ln_w = (const float*)d_in[12]; p.ln_b = (const float*)d_in[13]; p.sink = (const float*)d_in[14];
  p.w_out = (const float*)d_in[15]; p.final_g = (const float*)d_in[16];
  p.out = (float*)d_out;
  auto need = [](size_t n) -> size_t {
    return 32768 + (size_t)2 * 3584 * 1024 * 2 + (size_t)2 * 1024 * 1024 * 2 + n * (2048 + 5120 + 4608 + 2048 + 16 + 1536 + 48) + 8192 + (size_t)16384 * 32 * 8 + 256 + n * 128 + 256 + 2 * 64 * 256 * 8 + 256 + 2 * 4 * 256 * 64 * 2 + 256;
  };
  int npass = (ws_size >= need(NTOK)) ? 1 : 2;
  size_t n = NTOK / npass;
  char* w = (char*)d_ws; size_t off = 0;
  auto take = [&](size_t bytes) { char* r = w + off; off += (bytes + 255) & ~(size_t)255; return r; };
  p.bar = (unsigned*)take(32768);
  p.WinT = (bf16_t*)take((size_t)2 * 3584 * 1024 * 2);
  p.WoutT = (bf16_t*)take((size_t)2 * 1024 * 1024 * 2);
  p.Tb = (bf16_t*)take(n * 2048);
  p.proj2 = (bf16_t*)take(n * 5120);
  p.PX = (bf16_t*)take(n * 4608);
  p.yf = (bf16_t*)take(n * 512);
  p.yb = (bf16_t*)take(n * 512);
  p.xb2 = (bf16_t*)take(n * 1024);
  p.bonus = (float*)take(n * 16);
  p.obuf = (bf16_t*)take(n * 1536);
  p.lse = (float*)take(n * 48);
  p.ropetab = (float2*)take((size_t)16384 * 32 * 8);
  p.g16 = (float*)take(n / 16 * 512 * 4);
  p.lw = (uint2*)take((size_t)2 * 64 * 256 * 8);
  p.lwT = (bf16_t*)take((size_t)2 * 4 * 256 * 64 * 2);
  p.npass = npass; p.ntok_pass = (int)n;
  const int nph = 1 + 13 * npass;
  hipMemsetAsync(p.bar, 0, 32768, stream);
  int ph_lo = 0, ph_hi = nph;
  void* args[] = {(void*)&p, (void*)&ph_lo, (void*)&ph_hi};
  hipError_t e = hipLaunchCooperativeKernel((const void*)mega, dim3(grid_blocks), dim3(256), args, 0, stream);
  if (e != hipSuccess) fprintf(stderr, "cooperative launch failed: %s (grid %d)\n", hipGetErrorString(e), grid_blocks);
}
```
